# Optimizing an MI355X kernel written in HIP

```python
import math
import jax, jax.numpy as jnp
from jax import lax
import numpy as np

D_MODEL = 1024
BATCH = 32
SEQ = 2048
DEPTH = 2

MLA_HEADS = 8
MLA_NOPE = 64
MLA_ROPE = 32
MLA_V = 64
Q_LORA = 256
KV_LORA = 256
DIFF_HEADS = 4
DIFF_D = 64
D_FF = 4 * D_MODEL

MLA_WIDTH = MLA_HEADS * MLA_V
DIFF_WIDTH = DIFF_HEADS * 2 * DIFF_D
D_MIX = MLA_WIDTH + DIFF_WIDTH

OFF_CQ = 0
OFF_CKV = OFF_CQ + Q_LORA
OFF_KR = OFF_CKV + KV_LORA
OFF_DQ = OFF_KR + MLA_ROPE
OFF_DK = OFF_DQ + DIFF_HEADS * 2 * DIFF_D
OFF_DV = OFF_DK + DIFF_HEADS * 2 * DIFF_D
P_IN = OFF_DV + DIFF_HEADS * 2 * DIFF_D

Q_BLOCK = 128
ROPE_THETA = 10000.0
EPS = 1e-6
SUBLN_EPS = 1e-5

kernel_name = "hybrid_mla_diffattn_alibi_encoder"


def _rmsnorm(x, g, eps=EPS):
    xf = x.astype(jnp.float32)
    y = xf * lax.rsqrt(jnp.mean(xf * xf, axis=-1, keepdims=True) + eps)
    return (y * g.astype(jnp.float32)).astype(x.dtype)


def _rope(x, cos, sin):
    half = x.shape[-1] // 2
    xf = x.astype(jnp.float32)
    x1, x2 = xf[..., :half], xf[..., half:]
    return jnp.concatenate([x1 * cos - x2 * sin, x1 * sin + x2 * cos], axis=-1).astype(x.dtype)


def _alibi_slopes(n_heads):
    return jnp.exp2(-8.0 * (jnp.arange(n_heads, dtype=jnp.float32) + 1.0) / n_heads)


def _to_blocks(t):
    b, s = t.shape[:2]
    t = t.reshape((b, s // Q_BLOCK, Q_BLOCK) + t.shape[2:])
    return jnp.moveaxis(t, 1, 0)


def _from_blocks(t):
    t = jnp.moveaxis(t, 0, 1)
    return t.reshape((t.shape[0], t.shape[1] * t.shape[2]) + t.shape[3:])


def _mla_attention(q, k, v):
    scale = (MLA_NOPE + MLA_ROPE) ** -0.5

    def one_block(qb):
        s = jnp.einsum('bqhd,bkhd->bhqk', qb, k, preferred_element_type=jnp.float32) * scale
        p = jax.nn.softmax(s, axis=-1).astype(v.dtype)
        return jnp.einsum('bhqk,bkhd->bqhd', p, v)

    return _from_blocks(lax.map(one_block, _to_blocks(q)))


def _diff_attention(q, k, v, lam, slopes):
    s_len = k.shape[1]
    scale = DIFF_D ** -0.5
    kpos = jnp.arange(s_len, dtype=jnp.float32)
    starts = jnp.arange(s_len // Q_BLOCK, dtype=jnp.int32) * Q_BLOCK

    def one_block(args):
        qb, start = args
        qpos = (start + jnp.arange(Q_BLOCK, dtype=jnp.int32)).astype(jnp.float32)
        bias = -slopes[:, None, None] * jnp.abs(qpos[:, None] - kpos[None, :])
        s = jnp.einsum('bqhmd,bkhmd->bmhqk', qb, k,
                       preferred_element_type=jnp.float32) * scale + bias
        p = jax.nn.softmax(s, axis=-1)
        w = (p[:, 0] - lam * p[:, 1]).astype(v.dtype)
        return jnp.einsum('bhqk,bkhd->bqhd', w, v)

    return _from_blocks(lax.map(one_block, (_to_blocks(q), starts)))


def setup_inputs(seed: int = 0) -> dict:
    key = jax.random.key(seed)
    ks = jax.random.split(key, 18)
    f32 = jnp.float32
    L = DEPTH

    def w(k, shape, fan_in):
        return jax.random.normal(k, shape, f32) * (fan_in ** -0.5)

    def gain(k, shape):
        return 1.0 + 0.01 * jax.random.normal(k, shape, f32)

    return {
        "x": jax.random.normal(ks[0], (BATCH, SEQ, D_MODEL), f32),
        "w_in": w(ks[1], (L, D_MODEL, P_IN), D_MODEL),
        "g_mix": gain(ks[2], (L, D_MODEL)),
        "g_q": gain(ks[3], (L, Q_LORA)),
        "g_kv": gain(ks[4], (L, KV_LORA)),
        "w_uq": w(ks[5], (L, Q_LORA, MLA_HEADS * (MLA_NOPE + MLA_ROPE)), Q_LORA),
        "w_ukv": w(ks[6], (L, KV_LORA, MLA_HEADS * (MLA_NOPE + MLA_V)), KV_LORA),
        "lam_q1": 0.1 * jax.random.normal(ks[7], (L, DIFF_D), f32),
        "lam_k1": 0.1 * jax.random.normal(ks[8], (L, DIFF_D), f32),
        "lam_q2": 0.1 * jax.random.normal(ks[9], (L, DIFF_D), f32),
        "lam_k2": 0.1 * jax.random.normal(ks[10], (L, DIFF_D), f32),
        "g_sub": gain(ks[11], (L, 2 * DIFF_D)),
        "w_out": w(ks[12], (L, D_MIX, D_MODEL), D_MIX),
        "g_mlp": gain(ks[13], (L, D_MODEL)),
        "w_up": w(ks[14], (L, D_MODEL, D_FF), D_MODEL),
        "w_down": w(ks[15], (L, D_FF, D_MODEL), D_FF),
        "g_final": gain(ks[16], (D_MODEL,)),
    }


def reference(x, w_in, g_mix, g_q, g_kv, w_uq, w_ukv, lam_q1, lam_k1, lam_q2, lam_k2,
              g_sub, w_out, g_mlp, w_up, w_down, g_final):
    b, s, _ = x.shape
    pos = jnp.arange(s, dtype=jnp.float32)
    inv_freq = 1.0 / (ROPE_THETA ** (jnp.arange(0, MLA_ROPE, 2, dtype=jnp.float32) / MLA_ROPE))
    ang = pos[:, None] * inv_freq[None, :]
    cos, sin = jnp.cos(ang), jnp.sin(ang)
    slopes = _alibi_slopes(DIFF_HEADS)

    h = x
    for l in range(DEPTH):
        lam_init = 0.8 - 0.6 * math.exp(-0.3 * l)
        u = _rmsnorm(h, g_mix[l])
        z = u @ w_in[l]

        c_q = _rmsnorm(z[..., OFF_CQ:OFF_CKV], g_q[l])
        c_kv = _rmsnorm(z[..., OFF_CKV:OFF_KR], g_kv[l])
        k_rope = _rope(z[..., OFF_KR:OFF_DQ], cos, sin)
        q = (c_q @ w_uq[l]).reshape(b, s, MLA_HEADS, MLA_NOPE + MLA_ROPE)
        q = jnp.concatenate(
            [q[..., :MLA_NOPE], _rope(q[..., MLA_NOPE:], cos[:, None], sin[:, None])], axis=-1)
        kv = (c_kv @ w_ukv[l]).reshape(b, s, MLA_HEADS, MLA_NOPE + MLA_V)
        k = jnp.concatenate(
            [kv[..., :MLA_NOPE],
             jnp.broadcast_to(k_rope[:, :, None, :], (b, s, MLA_HEADS, MLA_ROPE))], axis=-1)
        o_mla = _mla_attention(q, k, kv[..., MLA_NOPE:]).reshape(b, s, MLA_WIDTH)

        dq = z[..., OFF_DQ:OFF_DK].reshape(b, s, DIFF_HEADS, 2, DIFF_D)
        dk = z[..., OFF_DK:OFF_DV].reshape(b, s, DIFF_HEADS, 2, DIFF_D)
        dv = z[..., OFF_DV:P_IN].reshape(b, s, DIFF_HEADS, 2 * DIFF_D)
        lam = (jnp.exp(jnp.sum(lam_q1[l].astype(jnp.float32) * lam_k1[l].astype(jnp.float32)))
               - jnp.exp(jnp.sum(lam_q2[l].astype(jnp.float32) * lam_k2[l].astype(jnp.float32)))
               + lam_init)
        o = _diff_attention(dq, dk, dv, lam, slopes)
        o = _rmsnorm(o, g_sub[l], SUBLN_EPS) * (1.0 - lam_init)
        o_diff = o.reshape(b, s, DIFF_WIDTH)

        h = h + jnp.concatenate([o_mla, o_diff], axis=-1) @ w_out[l]

        u = _rmsnorm(h, g_mlp[l])
        h = h + jnp.square(jax.nn.relu(u @ w_up[l])) @ w_down[l]

    return _rmsnorm(h, g_final)
```

```cpp
#include <hip/hip_runtime.h>
#include <hip/hip_bf16.h>
#include <hip/hip_cooperative_groups.h>
#include <cstdio>
#include <cstdint>
#include <cmath>
namespace cg = cooperative_groups;
#define GAS __attribute__((address_space(1)))
constexpr float K_LOG2E = 1.4426950408889634f;
constexpr float K_C2M = 0.10206207261596575f * K_LOG2E;
constexpr float K_C2D = 0.125f * K_LOG2E;
template <int MASK> __device__ __forceinline__ float xadd(float v) {
    if constexpr (MASK == 32) { auto rr = __builtin_amdgcn_permlane32_swap(__float_as_uint(v), __float_as_uint(v), false, false); return __uint_as_float(rr[0]) + __uint_as_float(rr[1]); }
    else return v + __int_as_float(__builtin_amdgcn_ds_swizzle(__float_as_int(v), 0x1F | (MASK << 10)));
}
namespace pg8 {
#define PG8_LAS __attribute__((address_space(3)))
typedef unsigned short bf16_t;
typedef short bf16x8 __attribute__((ext_vector_type(8)));
typedef float f32x4 __attribute__((ext_vector_type(4)));
typedef unsigned u32x4 __attribute__((ext_vector_type(4)));
constexpr int BM = 256, BK = 64, HALF = 128, HTB = HALF * BK * 2  , STAGE_BYTES = 8 * HTB, NXCD = 8, WGM = 8;

__host__ __device__ __forceinline__ int lds_byte(int r, int c) { const int st = (r >> 4) * 2 + (c >> 5), rr = r & 15, cc = c & 31, ob = rr * 64 + cc * 2; return st * 1024 + (ob ^ (((ob >> 9) & 1) << 5)); }
__host__ __device__ __forceinline__ void stage_rc(int b, int& R, int& C) { const int st = b / 1024, sb = b % 1024, swz = sb ^ (((sb >> 9) & 1) << 5); R = (st >> 1) * 16 + swz / 64; C = (st & 1) * 32 + (swz % 64) / 2; }
__host__ __device__ __forceinline__ int perm32(int rho) { const int n = rho >> 4, i = rho & 15; return 8 * (i >> 2) + 4 * n + (i & 3); }

struct Unit { int pm, pn; };
struct Gemm { const bf16_t* A; const bf16_t* Bt; int M, N, K; };

struct StaticOrder {
    int nM, nN, nwg, G, c;
    __host__ __device__ void init(int M, int N, int G_, int c_) { nM = M / BM; nN = N / BM; nwg = nM * nN; G = G_; c = c_; }
    __host__ __device__ bool next(int i, Unit& u) const {
        const long L = (long)i * G + c; if (L >= nwg) return false;
        int wgid = (int)L; { const int q = nwg / NXCD, r = nwg % NXCD, xcd = wgid % NXCD, off = wgid / NXCD; wgid = (xcd < r ? xcd * (q + 1) : r * (q + 1) + (xcd - r) * q) + off; }
        const int nig = WGM * nN, gid = wgid / nig, fm = gid * WGM, gsz = (nM - fm) < WGM ? (nM - fm) : WGM;
        u.pm = fm + ((wgid % nig) % gsz); u.pn = (wgid % nig) / gsz; return true;
    }
    __device__ __forceinline__ void a_ready(const Unit&) const {}
    __device__ __forceinline__ void done(const Unit&) const {}
};
__device__ __forceinline__ unsigned cvt_pk_bf16(float lo, float hi) { unsigned r; asm volatile("v_cvt_pk_bf16_f32 %0, %1, %2" : "=v"(r) : "v"(lo), "v"(hi)); return r; }
typedef float f32x2 __attribute__((ext_vector_type(2)));
typedef unsigned u32x2 __attribute__((ext_vector_type(2)));
__device__ __forceinline__ float dot4(f32x4 v) { return (v[0] * v[0] + v[1] * v[1]) + (v[2] * v[2] + v[3] * v[3]); }
__device__ __forceinline__ void st4bf(bf16_t* p, f32x4 v) { u32x2 w; w.x = cvt_pk_bf16(v[0], v[1]); w.y = cvt_pk_bf16(v[2], v[3]); *(GAS u32x2*)p = w; }
__device__ __forceinline__ void st8bf(bf16_t* p, f32x4 v0, f32x4 v1) { u32x4 w; w.x = cvt_pk_bf16(v0[0], v0[1]); w.y = cvt_pk_bf16(v0[2], v0[3]); w.z = cvt_pk_bf16(v1[0], v1[1]); w.w = cvt_pk_bf16(v1[2], v1[3]); *(GAS u32x4*)p = w; }
__device__ __forceinline__ float ssq16(const float* p) { const f32x4 a = *(const GAS f32x4*)p, b = *(const GAS f32x4*)(p + 4), c = *(const GAS f32x4*)(p + 8), d = *(const GAS f32x4*)(p + 12);
    return (((a[0] + a[1]) + (a[2] + a[3])) + ((b[0] + b[1]) + (b[2] + b[3]))) + (((c[0] + c[1]) + (c[2] + c[3])) + ((d[0] + d[1]) + (d[2] + d[3]))); }
__device__ __forceinline__ float ssq16q(const float* p, int fq) { const f32x4 a = *(const GAS f32x4*)(p + 4 * fq); float s = (a[0] + a[1]) + (a[2] + a[3]); s = xadd<16>(s); return xadd<32>(s); }
__device__ __forceinline__ float ssq4(const float* p) { const f32x4 a = *(const GAS f32x4*)p; return (a[0] + a[1]) + (a[2] + a[3]); }
template <int NP> __device__ __forceinline__ void row_scales(float (&rs)[2][4], const float* sq_row0  , int fq, float inv_n) {
#pragma unroll
    for (int ai = 0; ai < 2; ++ai) {
        f32x4 q[4];
#pragma unroll
        for (int m = 0; m < 4; ++m) q[m] = *(const GAS f32x4*)(sq_row0 + (size_t)(ai * HALF + m * 16) * 16 + (NP == 16 ? 4 * fq : 0));
#pragma unroll
        for (int m = 0; m < 4; ++m) { float t = (q[m][0] + q[m][1]) + (q[m][2] + q[m][3]); if (NP == 16) { t = xadd<16>(t); t = xadd<32>(t); } rs[ai][m] = rsqrtf(t * inv_n + 1e-6f); }
    }
}
constexpr size_t SSQ_ARR = (size_t)65536 * 16;
constexpr size_t ZO_CQ = (size_t)180 << 20, ZS_CQ = (size_t)32 << 20, ZO_DQ = (size_t)244 << 20, ZS_DQ = (size_t)64 << 20, ZO_KR = (size_t)436 << 20;
struct EpiZ {
    static constexpr bool PERM = true, AFTER_DRAIN = false;
    const float* ssq_h; float* ssq_q; unsigned char* ws; const float* cs;
    __device__ __forceinline__ void operator()(const f32x4 (&acc)[2][2][4][2], const Unit& u, int wr, int wc, int, int) const {
        int ln_; asm volatile("v_mbcnt_lo_u32_b32 %0, -1, 0\n\tv_mbcnt_hi_u32_b32 %0, -1, %0" : "=v"(ln_)); const int fr = ln_ & 15, fq = ln_ >> 4;
        const int pn = u.pn;
        float rsv[2][4]; row_scales<16>(rsv, ssq_h + (size_t)(u.pm * BM + wr * 64 + fr) * 16, fq, 1.f / 1024.f);
#pragma unroll
        for (int ai = 0; ai < 2; ++ai)
#pragma unroll
            for (int m = 0; m < 4; ++m) {
                const int row = u.pm * BM + ai * HALF + wr * 64 + m * 16 + fr;
                const float rs = rsv[ai][m];
                if (pn <= 1) {
                    bf16_t* dst = (bf16_t*)(ws + ZO_CQ + (size_t)pn * ZS_CQ) + (size_t)row * 256 + wc * 32 + fq * 8; float s = 0.f;
#pragma unroll
                    for (int bj = 0; bj < 2; ++bj) { const f32x4 v0 = acc[ai][bj][m][0] * rs, v1 = acc[ai][bj][m][1] * rs; s += dot4(v0) + dot4(v1); st8bf(dst + bj * HALF, v0, v1); }
                    s = xadd<16>(s); s = xadd<32>(s);
                    if (fq == 0) ((GAS float*)ssq_q)[(size_t)pn * SSQ_ARR + (size_t)row * 16 + wc] = s;
                } else if (pn <= 7) {
                    const int which = (pn - 2) >> 1; bf16_t* base = (bf16_t*)(ws + ZO_DQ + (size_t)which * ZS_DQ); const float sc = which == 0 ? rs * K_C2D : rs;
                    bf16_t* dst = base + (size_t)row * 512 + ((pn - 2) & 1) * 256 + wc * 32 + fq * 8;
#pragma unroll
                    for (int bj = 0; bj < 2; ++bj) st8bf(dst + bj * HALF, acc[ai][bj][m][0] * sc, acc[ai][bj][m][1] * sc);
                } else if (wc == 0) {
                    const f32x4 x1 = acc[ai][0][m][0] * rs, x2 = acc[ai][0][m][1] * rs; const int pos = row & 2047;
                    const f32x4 c = *(const GAS f32x4*)(cs + pos * 32 + fq * 4), s = *(const GAS f32x4*)(cs + pos * 32 + 16 + fq * 4);
                    bf16_t* KR = (bf16_t*)(ws + ZO_KR); st4bf(KR + (size_t)row * 32 + fq * 4, x1 * c - x2 * s); st4bf(KR + (size_t)row * 32 + 16 + fq * 4, x1 * s + x2 * c);
                }
            }
    }
};
struct EpiQ {
    static constexpr bool PERM = true, AFTER_DRAIN = false;
    const float* ssq_q; bf16_t* Q; const float* cs;
    __device__ __forceinline__ void operator()(const f32x4 (&acc)[2][2][4][2], const Unit& u, int wr, int wc, int, int) const {
        int ln_; asm volatile("v_mbcnt_lo_u32_b32 %0, -1, 0\n\tv_mbcnt_hi_u32_b32 %0, -1, %0" : "=v"(ln_)); const int fr = ln_ & 15, fq = ln_ >> 4;
        const int row0 = u.pm * BM + wr * 64 + fr;
        const float* csp = cs + (((u.pm * BM) & 2047) + wr * 64 + fr) * 32 + fq * 4;
        const float* sqp = ssq_q + (size_t)row0 * 16;
        bf16_t* qp = Q + (size_t)row0 * 768 + (8 * u.pn + wc) * 32;
        float rsv[2][4]; row_scales<4>(rsv, sqp, fq, 1.f / 256.f);
        const bool rope0 = ((8 * u.pn + wc) % 3) == 2, rope1 = ((8 * u.pn + 4 + wc) % 3) == 2;
#pragma unroll
        for (int ai = 0; ai < 2; ++ai)
#pragma unroll
            for (int m = 0; m < 4; ++m) {
                const int dr = ai * HALF + m * 16;
                const float rs = rsv[ai][m] * K_C2M;
                if (rope0 || rope1) {
                    const f32x4 c = *(const GAS f32x4*)(csp + dr * 32), s = *(const GAS f32x4*)(csp + dr * 32 + 16);
#pragma unroll
                    for (int bj = 0; bj < 2; ++bj) {
                        f32x4 x1 = acc[ai][bj][m][0] * rs, x2 = acc[ai][bj][m][1] * rs;
                        if (bj == 0 ? rope0 : rope1) { const f32x4 o1 = x1 * c - x2 * s, o2 = x1 * s + x2 * c; x1 = o1; x2 = o2; }
                        if (bj == 0 ? rope0 : rope1) { st4bf(qp + (size_t)dr * 768 + bj * 128 + fq * 4, x1); st4bf(qp + (size_t)dr * 768 + bj * 128 + 16 + fq * 4, x2); }
                        else st8bf(qp + (size_t)dr * 768 + bj * 128 + fq * 8, x1, x2);
                    }
                } else {
#pragma unroll
                    for (int bj = 0; bj < 2; ++bj) st8bf(qp + (size_t)dr * 768 + bj * 128 + fq * 8, acc[ai][bj][m][0] * rs, acc[ai][bj][m][1] * rs);
                }
            }
    }
};
template <int ACT, int NP> struct EpiRow {
    static constexpr bool PERM = true, AFTER_DRAIN = false;
    const float* ssq; float inv_n; bf16_t* O; int ldc;
    __device__ __forceinline__ void operator()(const f32x4 (&acc)[2][2][4][2], const Unit& u, int wr, int wc, int, int) const {
        int ln_; asm volatile("v_mbcnt_lo_u32_b32 %0, -1, 0\n\tv_mbcnt_hi_u32_b32 %0, -1, %0" : "=v"(ln_)); const int fr = ln_ & 15, fq = ln_ >> 4;
        float rsv[2][4]; row_scales<NP>(rsv, ssq + (size_t)(u.pm * BM + wr * 64 + fr) * 16, fq, inv_n);
#pragma unroll
        for (int ai = 0; ai < 2; ++ai)
#pragma unroll
            for (int m = 0; m < 4; ++m) {
                const int row = u.pm * BM + ai * HALF + wr * 64 + m * 16 + fr;
                const float rs = rsv[ai][m];
                bf16_t* dst = O + (size_t)row * ldc + u.pn * BM + wc * 32 + 8 * fq;
#pragma unroll
                for (int bj = 0; bj < 2; ++bj) { f32x4 v0 = acc[ai][bj][m][0] * rs, v1 = acc[ai][bj][m][1] * rs;
                    if (ACT == 1) { v0 = __builtin_elementwise_max(v0, (f32x4){0.f, 0.f, 0.f, 0.f}); v1 = __builtin_elementwise_max(v1, (f32x4){0.f, 0.f, 0.f, 0.f}); v0 = v0 * v0; v1 = v1 * v1; }
                    u32x4 w; w.x = cvt_pk_bf16(v0[0], v0[1]); w.y = cvt_pk_bf16(v0[2], v0[3]); w.z = cvt_pk_bf16(v1[0], v1[1]); w.w = cvt_pk_bf16(v1[2], v1[3]);
                    *(GAS u32x4*)(dst + bj * HALF) = w; }
            }
    }
};
struct EpiRes {
    static constexpr bool PERM = true, AFTER_DRAIN = false;
    bf16_t* hb; float* ssq;
    __device__ __forceinline__ void operator()(const f32x4 (&acc)[2][2][4][2], const Unit& u, int wr, int wc, int, int) const {
        int ln_; asm volatile("v_mbcnt_lo_u32_b32 %0, -1, 0\n\tv_mbcnt_hi_u32_b32 %0, -1, %0" : "=v"(ln_)); const int fr = ln_ & 15, fq = ln_ >> 4;
        bf16_t* hp0 = hb + (size_t)(u.pm * BM + wr * 64 + fr) * 1024 + u.pn * BM + wc * 32 + 8 * fq;
#pragma unroll
        for (int ai = 0; ai < 2; ++ai) {
            u32x4 b[4][2];
#pragma unroll
            for (int m = 0; m < 4; ++m)
#pragma unroll
                for (int bj = 0; bj < 2; ++bj) b[m][bj] = *(const GAS u32x4*)(hp0 + (size_t)(ai * HALF + m * 16) * 1024 + bj * HALF);
#pragma unroll
            for (int m = 0; m < 4; ++m) {
                const int row = u.pm * BM + ai * HALF + wr * 64 + m * 16 + fr; bf16_t* hp = hp0 + (size_t)(ai * HALF + m * 16) * 1024; float s = 0.f;
#pragma unroll
                for (int bj = 0; bj < 2; ++bj) {
                    f32x4 v0 = acc[ai][bj][m][0], v1 = acc[ai][bj][m][1]; const u32x4 bb = b[m][bj];
                    v0[0] += __uint_as_float(bb.x << 16); v0[1] += __uint_as_float(bb.x & 0xffff0000u); v0[2] += __uint_as_float(bb.y << 16); v0[3] += __uint_as_float(bb.y & 0xffff0000u);
                    v1[0] += __uint_as_float(bb.z << 16); v1[1] += __uint_as_float(bb.z & 0xffff0000u); v1[2] += __uint_as_float(bb.w << 16); v1[3] += __uint_as_float(bb.w & 0xffff0000u);
                    s += dot4(v0) + dot4(v1);
                    u32x4 w; w.x = cvt_pk_bf16(v0[0], v0[1]); w.y = cvt_pk_bf16(v0[2], v0[3]); w.z = cvt_pk_bf16(v1[0], v1[1]); w.w = cvt_pk_bf16(v1[2], v1[3]);
                    *(GAS u32x4*)(hp + bj * HALF) = w;
                }
                s = xadd<16>(s); s = xadd<32>(s);
                if (fq == 0) ((GAS float*)ssq)[(size_t)row * 16 + u.pn * 4 + wc] = s;
            }
        }
    }
};
template <class Epi, class Sched, bool ALIGN_EPI = false, bool SP2 = false>
__device__ __forceinline__ void gemm_phase(PG8_LAS unsigned char* lds, const Gemm g, const Sched& S, const Epi& E, const int wv) {
    int tid; asm volatile("v_mbcnt_lo_u32_b32 %0, -1, 0\n\tv_mbcnt_hi_u32_b32 %0, -1, %0" : "=v"(tid)); tid += wv * 64; const int wid = __builtin_amdgcn_readfirstlane(tid >> 6), lane = tid & 63, wr = wid >> 2, wc = wid & 3, fr = lane & 15, fq = lane >> 4;
    const int K = g.K, nt = K / BK;
    unsigned voffA[2], voffB[2];
#pragma unroll
    for (int i = 0; i < 2; ++i) { int R, C; stage_rc(tid * 16 + i * 8192, R, C); const int Rb = Epi::PERM ? ((R & ~31) + perm32(R & 31)) : R;
        voffA[i] = (unsigned)(R * K + C) * 2u; voffB[i] = (unsigned)(Rb * K + C) * 2u; }
    const size_t kstep = (size_t)(BK * 2);
    const size_t hstep = (size_t)HALF * K * 2;
    const size_t tstep = 2 * hstep;
    const unsigned ldsw = (unsigned)wid * 1024u;
    const int aoff = lds_byte(wr * 64 + fr, fq * 8), boff = lds_byte(wc * 32 + fr, fq * 8);
#define PG8_SA(b, h) (((b) * 2 + (h)) * HTB)
#define PG8_SB(b, h) ((4 + (b) * 2 + (h)) * HTB)
#define PG8_STAGE(bufoff, gbase, voff) do { _Pragma("unroll") for (int _i = 0; _i < 2; ++_i) \
        __builtin_amdgcn_global_load_lds((const unsigned*)((const char*)(gbase) + (voff)[_i]), (PG8_LAS unsigned*)(lds + (bufoff) + ldsw + _i * 8192), 16, 0, 0); } while (0)
#define PG8_LDA(dst, b, h) do { _Pragma("unroll") for (int m = 0; m < 4; ++m) _Pragma("unroll") for (int k = 0; k < 2; ++k) dst[m][k] = *(const PG8_LAS bf16x8*)(lds + PG8_SA(b, h) + aoff + m * 2048 + k * 1024); } while (0)
#define PG8_LDB(dst, b, h) do { _Pragma("unroll") for (int n = 0; n < 2; ++n) _Pragma("unroll") for (int k = 0; k < 2; ++k) dst[n][k] = *(const PG8_LAS bf16x8*)(lds + PG8_SB(b, h) + boff + n * 2048 + k * 1024); } while (0)
#define PG8_MMA(ai, bj, At, Bt) do { __builtin_amdgcn_s_setprio(1); _Pragma("unroll") for (int m = 0; m < 4; ++m) _Pragma("unroll") for (int n = 0; n < 2; ++n) _Pragma("unroll") for (int k = 0; k < 2; ++k) \
        acc[ai][bj][m][n] = __builtin_amdgcn_mfma_f32_16x16x32_bf16(Bt[n][k], At[m][k], acc[ai][bj][m][n], 0, 0, 0); __builtin_amdgcn_s_setprio(0); } while (0)
#define PG8_WAIT_V(n) asm volatile("s_waitcnt vmcnt(" #n ")" ::: "memory")
#define PG8_WAIT_L(n) asm volatile("s_waitcnt lgkmcnt(" #n ")" ::: "memory")
#define PG8_BAR __builtin_amdgcn_s_barrier()
#define PG8_SCHED __builtin_amdgcn_sched_barrier(0)
    Unit cur, nxt; int ui = 0;
    if (!S.next(0, cur)) return;
    f32x4 acc[2][2][4][2]; float zf = 0.f; asm volatile("" : "+v"(zf));
#pragma unroll
    for (int a = 0; a < 2; ++a)
#pragma unroll
        for (int b = 0; b < 2; ++b)
#pragma unroll
            for (int m = 0; m < 4; ++m)
#pragma unroll
                for (int n = 0; n < 2; ++n) acc[a][b][m][n] = (f32x4){zf, zf, zf, zf};
    bf16x8 At[4][2], B0[2][2], B1[2][2];
    const char* cA = (const char*)g.A + (size_t)cur.pm * tstep; const char* cB = (const char*)g.Bt + (size_t)cur.pn * tstep;
    S.a_ready(cur);
    if constexpr (SP2) {
        PG8_STAGE(PG8_SB(0, 0), cB, voffB); PG8_STAGE(PG8_SB(0, 1), cB + hstep, voffB); PG8_STAGE(PG8_SA(0, 0), cA, voffA); PG8_STAGE(PG8_SA(0, 1), cA + hstep, voffA);
        if (wr == 1) PG8_BAR;
        PG8_WAIT_V(2); PG8_BAR;
        PG8_STAGE(PG8_SB(1, 0), cB + kstep, voffB); PG8_STAGE(PG8_SA(1, 0), cA + kstep, voffA); PG8_STAGE(PG8_SB(1, 1), cB + hstep + kstep, voffB);
        PG8_WAIT_V(6); PG8_BAR;
    } else {
        PG8_STAGE(PG8_SB(0, 0), cB, voffB); PG8_STAGE(PG8_SA(0, 0), cA, voffA); PG8_STAGE(PG8_SB(0, 1), cB + hstep, voffB); PG8_STAGE(PG8_SA(0, 1), cA + hstep, voffA);
        if (wr == 1) PG8_BAR;
        PG8_WAIT_V(4); PG8_BAR;
        PG8_STAGE(PG8_SB(1, 0), cB + kstep, voffB); PG8_STAGE(PG8_SA(1, 0), cA + kstep, voffA); PG8_STAGE(PG8_SB(1, 1), cB + hstep + kstep, voffB);
        PG8_WAIT_V(6); PG8_BAR;
    }
    for (;;) {
        const bool has_next = S.next(ui + 1, nxt);
        const char* nA = has_next ? (const char*)g.A + (size_t)nxt.pm * tstep : cA; const char* nB = has_next ? (const char*)g.Bt + (size_t)nxt.pn * tstep : cB;
        for (int t = 0; t < nt; t += 2) {
            const bool last = (t == nt - 2);
            const char* a1 = cA + (size_t)(t + 1) * kstep;
            const char* a2 = last ? nA : cA + (size_t)(t + 2) * kstep; const char* b2 = last ? nB : cB + (size_t)(t + 2) * kstep;
            const char* a3 = a2 + kstep; const char* b3 = b2 + kstep;
            if (last && has_next) S.a_ready(nxt);
            if constexpr (SP2) {
            PG8_LDB(B0, 0, 0); PG8_LDB(B1, 0, 1); PG8_SCHED; PG8_LDA(At, 0, 0); PG8_STAGE(PG8_SA(1, 1), a1 + hstep, voffA);
            PG8_WAIT_V(8); PG8_WAIT_L(0); PG8_BAR; PG8_MMA(0, 0, At, B0); PG8_MMA(0, 1, At, B1); PG8_BAR; PG8_SCHED;
            PG8_LDA(At, 0, 1); PG8_STAGE(PG8_SB(0, 0), b2, voffB); PG8_STAGE(PG8_SB(0, 1), b2 + hstep, voffB); PG8_STAGE(PG8_SA(0, 0), a2, voffA);
            PG8_WAIT_V(8); PG8_WAIT_L(0); PG8_BAR; PG8_MMA(1, 0, At, B0); PG8_MMA(1, 1, At, B1); PG8_BAR; PG8_SCHED;
            PG8_LDB(B0, 1, 0); PG8_LDB(B1, 1, 1); PG8_SCHED; PG8_LDA(At, 1, 0); PG8_STAGE(PG8_SA(0, 1), a2 + hstep, voffA);
            PG8_WAIT_V(8); PG8_WAIT_L(0); PG8_BAR; PG8_MMA(0, 0, At, B0); PG8_MMA(0, 1, At, B1); PG8_BAR; PG8_SCHED;
            PG8_LDA(At, 1, 1); PG8_STAGE(PG8_SB(1, 0), b3, voffB); PG8_STAGE(PG8_SB(1, 1), b3 + hstep, voffB); PG8_STAGE(PG8_SA(1, 0), a3, voffA);
            PG8_WAIT_V(8); PG8_WAIT_L(0); PG8_BAR; PG8_MMA(1, 0, At, B0); PG8_MMA(1, 1, At, B1); PG8_BAR; PG8_SCHED;
            } else {
            PG8_LDB(B0, 0, 0); PG8_SCHED; PG8_LDA(At, 0, 0); PG8_STAGE(PG8_SA(1, 1), a1 + hstep, voffA);
            PG8_WAIT_L(8); PG8_BAR; PG8_WAIT_L(0); PG8_MMA(0, 0, At, B0); PG8_BAR; PG8_SCHED;
            PG8_LDB(B1, 0, 1); PG8_STAGE(PG8_SB(0, 0), b2, voffB);
            PG8_BAR; PG8_WAIT_L(0); PG8_MMA(0, 1, At, B1); PG8_BAR;
            PG8_LDA(At, 0, 1); PG8_STAGE(PG8_SA(0, 0), a2, voffA);
            PG8_BAR; PG8_WAIT_L(0); PG8_MMA(1, 0, At, B0); PG8_BAR; PG8_SCHED;
            PG8_STAGE(PG8_SB(0, 1), b2 + hstep, voffB);
            PG8_WAIT_V(6); PG8_BAR; PG8_MMA(1, 1, At, B1); PG8_BAR;
            PG8_LDB(B0, 1, 0); PG8_SCHED; PG8_LDA(At, 1, 0); PG8_STAGE(PG8_SA(0, 1), a2 + hstep, voffA);
            PG8_WAIT_L(8); PG8_BAR; PG8_WAIT_L(0); PG8_MMA(0, 0, At, B0); PG8_BAR; PG8_SCHED;
            PG8_LDB(B1, 1, 1); PG8_STAGE(PG8_SB(1, 0), b3, voffB);
            PG8_BAR; PG8_WAIT_L(0); PG8_MMA(0, 1, At, B1); PG8_BAR;
            PG8_LDA(At, 1, 1); PG8_STAGE(PG8_SA(1, 0), a3, voffA);
            PG8_BAR; PG8_WAIT_L(0); PG8_MMA(1, 0, At, B0); PG8_BAR; PG8_SCHED;
            PG8_STAGE(PG8_SB(1, 1), b3 + hstep, voffB);
            PG8_WAIT_V(6); PG8_BAR; PG8_MMA(1, 1, At, B1); PG8_BAR;
            }
        }
        if constexpr (ALIGN_EPI) { if (wr == 0) PG8_BAR; }
        if constexpr (!Epi::AFTER_DRAIN) { E(acc, cur, wr, wc, fr, fq); S.done(cur); }
        if (!has_next) break;
        asm volatile("" : "+v"(zf));
#pragma unroll
        for (int a = 0; a < 2; ++a)
#pragma unroll
            for (int b = 0; b < 2; ++b)
#pragma unroll
                for (int m = 0; m < 4; ++m)
#pragma unroll
                    for (int n = 0; n < 2; ++n) acc[a][b][m][n] = (f32x4){zf, zf, zf, zf};
        cur = nxt; cA = nA; cB = nB; ++ui;
        if constexpr (ALIGN_EPI) { if (wr == 1) PG8_BAR; }
    }
    PG8_WAIT_V(0);
    if constexpr (!ALIGN_EPI) { if (wr == 0) PG8_BAR; }
    PG8_BAR;
    if constexpr (Epi::AFTER_DRAIN) { E.fused(acc, cur, wr, wc, fr, fq, lds, wid, lane); S.done(cur); }
#undef PG8_SA
#undef PG8_SB
#undef PG8_STAGE
#undef PG8_LDA
#undef PG8_LDB
#undef PG8_MMA
#undef PG8_WAIT_V
#undef PG8_WAIT_L
#undef PG8_BAR
#undef PG8_SCHED
}
}
namespace att {
using bf16 = __hip_bfloat16;
using bf16x8 = __attribute__((ext_vector_type(8))) short;
using s16x4  = __attribute__((ext_vector_type(4))) short;
using f32x16 = __attribute__((ext_vector_type(16))) float;
using u32x4  = __attribute__((ext_vector_type(4))) unsigned;
constexpr int NW = 8, QBLK = 32, KVBLK = 64, SEQ = 2048;
constexpr float THR2 = 11.5f;
#define KSWZ(row, colB) ((row) * 256 + ((colB) ^ (((row) & 7) << 4)))
#define SBAR() __builtin_amdgcn_sched_barrier(0)
__device__ __forceinline__ int crow(int r, int hi) { return (r & 3) + 8 * (r >> 2) + 4 * hi; }
__device__ __forceinline__ unsigned cvtpk(float lo, float hi) { unsigned r; asm volatile("v_cvt_pk_bf16_f32 %0, %1, %2" : "=v"(r) : "v"(lo), "v"(hi)); return r; }
__device__ __forceinline__ bf16x8 ld8(const bf16* p) { return *(const GAS bf16x8*)p; }
__device__ __forceinline__ void partialSM(f32x16& p0, f32x16& p1, float& m_reg, float& alpha) {
  float pmax = p0[0];
#pragma unroll
  for (int r = 1; r < 16; ++r) pmax = fmaxf(pmax, p0[r]);
#pragma unroll
  for (int r = 0; r < 16; ++r) pmax = fmaxf(pmax, p1[r]);
  { auto rr = __builtin_amdgcn_permlane32_swap(__float_as_uint(pmax), __float_as_uint(pmax), false, false);
    pmax = fmaxf(__uint_as_float(rr[0]), __uint_as_float(rr[1])); }
  float mn;
  if (__builtin_expect(__all(pmax - m_reg <= THR2), 1)) { mn = m_reg; alpha = 1.f; }
  else { mn = fmaxf(m_reg, pmax); alpha = __builtin_amdgcn_exp2f(m_reg - mn); m_reg = mn; }
#pragma unroll
  for (int r = 0; r < 16; ++r) { p0[r] -= mn; p1[r] -= mn; }
#pragma unroll
  for (int r = 0; r < 16; ++r) p0[r] = __builtin_amdgcn_exp2f(p0[r]);
}
__device__ __forceinline__ void partialSM_neg(f32x16& p0, f32x16& p1, float& m_reg, f32x16& negm, float& alpha, const bool first) {
  float pmax = p0[0];
#pragma unroll
  for (int r = 1; r < 16; ++r) pmax = fmaxf(pmax, p0[r]);
#pragma unroll
  for (int r = 0; r < 16; ++r) pmax = fmaxf(pmax, p1[r]);
  { auto rr = __builtin_amdgcn_permlane32_swap(__float_as_uint(pmax), __float_as_uint(pmax), false, false);
    pmax = fmaxf(__uint_as_float(rr[0]), __uint_as_float(rr[1])); }
  alpha = 1.f;
  if (first || !__all(pmax <= THR2)) { const float dl = first ? pmax : fmaxf(pmax, 0.f); m_reg += dl; if (!first) alpha = __builtin_amdgcn_exp2f(-dl);
#pragma unroll
    for (int r = 0; r < 16; ++r) { p0[r] -= dl; p1[r] -= dl; }
#pragma unroll
    for (int r = 0; r < 16; ++r) negm[r] = -m_reg;
    asm volatile("" : "+v"(negm)); }
#pragma unroll
  for (int r = 0; r < 16; ++r) p0[r] = __builtin_amdgcn_exp2f(p0[r]);
}
__device__ __forceinline__ void finishSM(f32x16& p0, f32x16& p1, bf16x8& pa0, bf16x8& pa1, bf16x8& pa2, bf16x8& pa3) {
#pragma unroll
  for (int r = 0; r < 16; ++r) p1[r] = __builtin_amdgcn_exp2f(p1[r]);
#define PK4(P, BASE, OUT) do { unsigned a0 = cvtpk(P[BASE + 0], P[BASE + 1]), a1 = cvtpk(P[BASE + 2], P[BASE + 3]);   \
    unsigned b0 = cvtpk(P[BASE + 4], P[BASE + 5]), b1 = cvtpk(P[BASE + 6], P[BASE + 7]);                              \
    auto r0 = __builtin_amdgcn_permlane32_swap(a0, b0, false, false); auto r1 = __builtin_amdgcn_permlane32_swap(a1, b1, false, false); \
    u32x4 w = {r0[0], r1[0], r0[1], r1[1]}; OUT = *reinterpret_cast<bf16x8*>(&w); } while (0)
  PK4(p0, 0, pa0); PK4(p0, 8, pa1); PK4(p1, 0, pa2); PK4(p1, 8, pa3);
#undef PK4
}
template <int NCB> __device__ __forceinline__ int v_st(int k, int c) { const int kk = (k & ~0xC) | ((k & 4) << 1) | ((k & 8) >> 1); return ((kk >> 3) * NCB + (c >> 5)) * 512 + ((kk & 7) * 32 + (c & 31)) * 2; }
__device__ __forceinline__ int v_rd_base(int lane) { return ((lane & 3) << 3) | (((lane >> 2) & 3) << 6) | (((lane >> 4) & 1) << 5) | (((lane >> 5) & 1) << 8); }
template <int OFF> __device__ __forceinline__ s16x4 tr_read(int vb) { s16x4 r; asm volatile("ds_read_b64_tr_b16 %0, %1 offset:%2" : "=&v"(r) : "v"(vb), "i"(OFF) : "memory"); return r; }
template <int NCB, int D0> __device__ __forceinline__ void pv_one(f32x16& od, int vb, bf16x8 pa0, bf16x8 pa1, bf16x8 pa2, bf16x8 pa3) {
#define VO(ks, half) (((2 * (ks) + (half)) * NCB + D0) * 512)
  const s16x4 l0 = tr_read<VO(0, 0)>(vb), h0 = tr_read<VO(0, 1)>(vb), l1 = tr_read<VO(1, 0)>(vb), h1 = tr_read<VO(1, 1)>(vb);
  const s16x4 l2 = tr_read<VO(2, 0)>(vb), h2 = tr_read<VO(2, 1)>(vb), l3 = tr_read<VO(3, 0)>(vb), h3 = tr_read<VO(3, 1)>(vb);
#undef VO
  asm volatile("s_waitcnt lgkmcnt(0)" ::: "memory"); SBAR();
#define PK(L, H) (bf16x8){L[0], L[1], L[2], L[3], H[0], H[1], H[2], H[3]}
  od = __builtin_amdgcn_mfma_f32_32x32x16_bf16(pa0, PK(l0, h0), od, 0, 0, 0);
  od = __builtin_amdgcn_mfma_f32_32x32x16_bf16(pa1, PK(l1, h1), od, 0, 0, 0);
  od = __builtin_amdgcn_mfma_f32_32x32x16_bf16(pa2, PK(l2, h2), od, 0, 0, 0);
  od = __builtin_amdgcn_mfma_f32_32x32x16_bf16(pa3, PK(l3, h3), od, 0, 0, 0);
#undef PK
}

__device__ __forceinline__ void lsum_mma(f32x16& lacc, bf16x8 pa0, bf16x8 pa1, bf16x8 pa2, bf16x8 pa3) {
  const short one = (short)0x3F80; const bf16x8 ones = {one, one, one, one, one, one, one, one};
  lacc = __builtin_amdgcn_mfma_f32_32x32x16_bf16(pa0, ones, lacc, 0, 0, 0); lacc = __builtin_amdgcn_mfma_f32_32x32x16_bf16(pa1, ones, lacc, 0, 0, 0);
  lacc = __builtin_amdgcn_mfma_f32_32x32x16_bf16(pa2, ones, lacc, 0, 0, 0); lacc = __builtin_amdgcn_mfma_f32_32x32x16_bf16(pa3, ones, lacc, 0, 0, 0);
}
constexpr int MLA_KROW = 208;
constexpr int MLA_SHV = 64 * 64 * 2, MLA_SHK = 64 * MLA_KROW;
__device__ __forceinline__ void mla_kload(bf16x8* kf, const char* Ks, int r32, int hi) {
#pragma unroll
  for (int d0 = 0; d0 < 6; ++d0) { const int cb = (d0 * 16 + hi * 8) * 2;
    kf[2 * d0] = *reinterpret_cast<const bf16x8*>(Ks + r32 * MLA_KROW + cb); kf[2 * d0 + 1] = *reinterpret_cast<const bf16x8*>(Ks + (32 + r32) * MLA_KROW + cb); }
}
__device__ __forceinline__ void mla_qkt(f32x16& p0, f32x16& p1, const bf16x8* kf, const bf16x8* qr, const f32x16& negm) {
  p0 = __builtin_amdgcn_mfma_f32_32x32x16_bf16(kf[0], qr[0], negm, 0, 0, 0);
  p1 = __builtin_amdgcn_mfma_f32_32x32x16_bf16(kf[1], qr[0], negm, 0, 0, 0);
#pragma unroll
  for (int d0 = 1; d0 < 6; ++d0) {
    p0 = __builtin_amdgcn_mfma_f32_32x32x16_bf16(kf[2 * d0], qr[d0], p0, 0, 0, 0);
    p1 = __builtin_amdgcn_mfma_f32_32x32x16_bf16(kf[2 * d0 + 1], qr[d0], p1, 0, 0, 0); }
}
__device__ __forceinline__ void mla_pv(f32x16* o, int vb, bf16x8 pa0, bf16x8 pa1, bf16x8 pa2, bf16x8 pa3) {
  pv_one<2, 0>(o[0], vb, pa0, pa1, pa2, pa3); pv_one<2, 1>(o[1], vb, pa0, pa1, pa2, pa3); lsum_mma(o[2], pa0, pa1, pa2, pa3);
}
__device__ __forceinline__ void mla_unit(const bf16* __restrict__ Qb, const bf16* __restrict__ Kn, const bf16* __restrict__ Kr, bf16* __restrict__ Ob, char* lds, const int wv) {
  int tid; asm volatile("v_mbcnt_lo_u32_b32 %0, -1, 0\n\tv_mbcnt_hi_u32_b32 %0, -1, %0" : "=v"(tid)); tid += wv * 64; const int wid = __builtin_amdgcn_readfirstlane(tid >> 6), lane = tid & 63, r32 = lane & 31, hi = lane >> 5;
  const bf16* Vh = Kn + 64;
  char* V_lds = lds; char* K_lds = lds + 4 * MLA_SHV;
  float* ws = (float*)(lds + 4 * MLA_SHV + 4 * MLA_SHK) + wid * 64; float* al_l = ws + 32;
  float m_reg = 0.f; f32x16 o[3] = {}; bf16x8 qr[6]; f32x16 negm = {}; asm volatile("" : "+v"(negm));
  const bf16* Qw = Qb + (long)(wid * QBLK + r32) * 768 + hi * 8;
#pragma unroll
  for (int d0 = 0; d0 < 6; ++d0) qr[d0] = ld8(Qw + d0 * 16);
  const int sr = tid >> 3, sc = (tid & 7) * 8, rr = (tid >> 2) & 63, rc = (tid & 3) * 8;
  const int vst = v_st<2>(sr, sc), kst = sr * MLA_KROW + sc * 2, krst = rr * MLA_KROW + 128 + rc * 2;
  const int vb0 = (int)(uintptr_t)V_lds + v_rd_base(lane);
  struct { bf16x8 vs, kn, kr; } sg[2];
#define SLOAD(s, k0) do { sg[s].vs = ld8(&Vh[(long)((k0) + sr) * 1024 + sc]); sg[s].kn = ld8(&Kn[(long)((k0) + sr) * 1024 + sc]); sg[s].kr = ld8(&Kr[(long)((k0) + rr) * 32 + rc]); } while (0)
#define SWRITE(b, s) do { *(bf16x8*)(V_lds + (b) * MLA_SHV + vst) = sg[s].vs; *(bf16x8*)(K_lds + (b) * MLA_SHK + kst) = sg[s].kn; *(bf16x8*)(K_lds + (b) * MLA_SHK + krst) = sg[s].kr; } while (0)
#define RESC(a) do { if (__any((a) < 1.f)) { if (hi == 0) al_l[r32] = (a); asm volatile("s_waitcnt lgkmcnt(0)" ::: "memory"); \
    _Pragma("unroll") for (int d = 0; d < 3; ++d) _Pragma("unroll") for (int r = 0; r < 16; ++r) o[d][r] *= al_l[crow(r, hi)]; } } while (0)
  f32x16 p0, p1; float al; bf16x8 pa0, pa1, pa2, pa3; const int NT = SEQ / KVBLK;
  SLOAD(0, 0); SLOAD(1, KVBLK); asm volatile("s_waitcnt vmcnt(0)" ::: "memory"); SWRITE(0, 0); SWRITE(1, 1); SLOAD(0, 2 * KVBLK); __syncthreads();
  { bf16x8 kf[12]; mla_kload(kf, K_lds, r32, hi); mla_qkt(p0, p1, kf, qr, negm); }
  if (wid >= 4) __syncthreads();
  for (int i = 0; i < NT; ++i) {
    __syncthreads();
    partialSM_neg(p0, p1, m_reg, negm, al, i == 0); finishSM(p0, p1, pa0, pa1, pa2, pa3);
    if (i + 2 < NT) { SWRITE((i + 2) & 3, 0); if (i + 3 < NT) SLOAD(0, (i + 3) * KVBLK); }
    RESC(al);
    __syncthreads();
    __builtin_amdgcn_s_setprio(1); SBAR();
    if (i + 1 < NT) { bf16x8 kf[12]; mla_kload(kf, K_lds + ((i + 1) & 3) * MLA_SHK, r32, hi); SBAR(); mla_qkt(p0, p1, kf, qr, negm); }
    mla_pv(o, vb0 + (i & 3) * MLA_SHV, pa0, pa1, pa2, pa3); __builtin_amdgcn_s_setprio(0);
  }
  if (wid < 4) __syncthreads();
  float rli[16];
#pragma unroll
  for (int r = 0; r < 16; ++r) rli[r] = __builtin_amdgcn_rcpf(o[2][r]);
  __syncthreads();
  { bf16* stg = (bf16*)(lds + wid * 4096);
#pragma unroll
    for (int r = 0; r < 16; ++r) { const int orow = crow(r, hi);
#pragma unroll
      for (int d0 = 0; d0 < 2; ++d0) stg[orow * 64 + d0 * 32 + r32] = __float2bfloat16(o[d0][r] * rli[r]); }
    asm volatile("s_waitcnt lgkmcnt(0)" ::: "memory");
    bf16* Ow = Ob + (long)(wid * QBLK) * 1024;
#pragma unroll
    for (int i = 0; i < 4; ++i) { const int row = i * 8 + (lane >> 3), ch = lane & 7; const u32x4 v = *(const u32x4*)(stg + row * 64 + ch * 8); *(GAS u32x4*)(Ow + (long)row * 1024 + ch * 8) = v; } }
  __syncthreads();
#undef SLOAD
#undef SWRITE
#undef RESC
}

constexpr int DF_SH = 64 * 128 * 2;
__device__ __forceinline__ void df_kload(bf16x8* kf, const char* Ks, int r32, int hi, int mapc) {
#pragma unroll
  for (int d0 = 0; d0 < 4; ++d0) { const int cb = mapc + (d0 * 16 + hi * 8) * 2;
    kf[2 * d0] = *reinterpret_cast<const bf16x8*>(Ks + KSWZ(r32, cb)); kf[2 * d0 + 1] = *reinterpret_cast<const bf16x8*>(Ks + KSWZ(32 + r32, cb)); }
}
__device__ __forceinline__ void df_qkt(f32x16& p0, f32x16& p1, const bf16x8* kf, const bf16x8* qr) {
  p0 = f32x16{}; p1 = f32x16{};
#pragma unroll
  for (int d0 = 0; d0 < 4; ++d0) {
    p0 = __builtin_amdgcn_mfma_f32_32x32x16_bf16(kf[2 * d0], qr[d0], p0, 0, 0, 0);
    p1 = __builtin_amdgcn_mfma_f32_32x32x16_bf16(kf[2 * d0 + 1], qr[d0], p1, 0, 0, 0); }
}
__device__ __forceinline__ void df_bias(f32x16& p0, f32x16& p1, float dbase, float nslope2) {
#pragma unroll
  for (int r = 0; r < 16; ++r) { const float c = (float)((r & 3) + 8 * (r >> 2));
    p0[r] = fmaf(fabsf(dbase + c), nslope2, p0[r]); p1[r] = fmaf(fabsf(dbase + (c + 32.f)), nslope2, p1[r]); }
}
__device__ __forceinline__ void df_pv(f32x16* o, int vb, bf16x8 pa0, bf16x8 pa1, bf16x8 pa2, bf16x8 pa3) {
  pv_one<4, 0>(o[0], vb, pa0, pa1, pa2, pa3); pv_one<4, 1>(o[1], vb, pa0, pa1, pa2, pa3); pv_one<4, 2>(o[2], vb, pa0, pa1, pa2, pa3); pv_one<4, 3>(o[3], vb, pa0, pa1, pa2, pa3); lsum_mma(o[4], pa0, pa1, pa2, pa3);
}
__device__ __forceinline__ void diff_unit(const bf16* __restrict__ Qb, const bf16* __restrict__ Kh, const bf16* __restrict__ Vh, bf16* __restrict__ Ob, int qpos0,
                                          float nslope2, float lam, const float* __restrict__ gsub, float outscale, char* lds, const int wv) {
  int tid; asm volatile("v_mbcnt_lo_u32_b32 %0, -1, 0\n\tv_mbcnt_hi_u32_b32 %0, -1, %0" : "=v"(tid)); tid += wv * 64; const int wid = __builtin_amdgcn_readfirstlane(tid >> 6), lane = tid & 63, r32 = lane & 31, hi = lane >> 5;
  const int map = wid >> 2, wq = wid & 3, mapc = map * 128;
  char* V_lds = lds; char* K_lds = lds + 4 * DF_SH;
  float* ws = (float*)(lds + 8 * DF_SH) + wid * 64; float* al_l = ws + 32;
  float m_reg = -1e30f; f32x16 o[5] = {}; bf16x8 qr[4];
  const bf16* Qw = Qb + (long)(wq * QBLK + r32) * 512 + map * 64 + hi * 8;
#pragma unroll
  for (int d0 = 0; d0 < 4; ++d0) qr[d0] = ld8(Qw + d0 * 16);
  const float dq0 = (float)(4 * hi - (qpos0 + wq * QBLK + r32));
  const int sr = tid >> 4, sc = (tid & 15) * 8, vst0 = v_st<4>(sr, sc), vst1 = v_st<4>(32 + sr, sc);
  const int vb0 = (int)(uintptr_t)V_lds + v_rd_base(lane);
  struct { bf16x8 vs0, vs1, ks0, ks1; } sg[2];
#define SLOAD(s, k0) do { sg[s].vs0 = ld8(&Vh[(long)((k0) + sr) * 512 + sc]); sg[s].vs1 = ld8(&Vh[(long)((k0) + 32 + sr) * 512 + sc]); \
    sg[s].ks0 = ld8(&Kh[(long)((k0) + sr) * 512 + sc]); sg[s].ks1 = ld8(&Kh[(long)((k0) + 32 + sr) * 512 + sc]); } while (0)
#define SWRITE(b, s) do { *(bf16x8*)(V_lds + (b) * DF_SH + vst0) = sg[s].vs0; *(bf16x8*)(V_lds + (b) * DF_SH + vst1) = sg[s].vs1; const int kc = sc * 2; \
    *(bf16x8*)(K_lds + (b) * DF_SH + KSWZ(sr, kc)) = sg[s].ks0; *(bf16x8*)(K_lds + (b) * DF_SH + KSWZ(32 + sr, kc)) = sg[s].ks1; } while (0)
#define RESC(a) do { if (__any((a) < 1.f)) { if (hi == 0) al_l[r32] = (a); asm volatile("s_waitcnt lgkmcnt(0)" ::: "memory"); \
    _Pragma("unroll") for (int d = 0; d < 5; ++d) _Pragma("unroll") for (int r = 0; r < 16; ++r) o[d][r] *= al_l[crow(r, hi)]; } } while (0)
  f32x16 p0, p1; float al; bf16x8 pa0, pa1, pa2, pa3; const int NT = SEQ / KVBLK;
  SLOAD(0, 0); SLOAD(1, KVBLK); asm volatile("s_waitcnt vmcnt(0)" ::: "memory"); SWRITE(0, 0); SWRITE(1, 1); SLOAD(0, 2 * KVBLK); __syncthreads();
  { bf16x8 kf[8]; df_kload(kf, K_lds, r32, hi, mapc); df_qkt(p0, p1, kf, qr); }
  if (wid >= 4) __syncthreads();
  for (int i = 0; i < NT; ++i) {
    __syncthreads();
    df_bias(p0, p1, dq0 + (float)(i * KVBLK), nslope2); partialSM(p0, p1, m_reg, al); finishSM(p0, p1, pa0, pa1, pa2, pa3);
    if (i + 2 < NT) { SWRITE((i + 2) & 3, 0); if (i + 3 < NT) SLOAD(0, (i + 3) * KVBLK); }
    RESC(al);
    __syncthreads();
    __builtin_amdgcn_s_setprio(1); SBAR();
    if (i + 1 < NT) { bf16x8 kf[8]; df_kload(kf, K_lds + ((i + 1) & 3) * DF_SH, r32, hi, mapc); SBAR(); df_qkt(p0, p1, kf, qr); }
    df_pv(o, vb0 + (i & 3) * DF_SH, pa0, pa1, pa2, pa3); __builtin_amdgcn_s_setprio(0);
  }
  if (wid < 4) __syncthreads();
  float rli[16]; const float msc = map ? -lam : 1.f;
#pragma unroll
  for (int r = 0; r < 16; ++r) rli[r] = __builtin_amdgcn_rcpf(o[4][r]) * msc;
  __syncthreads();
  float* X = (float*)lds + wq * 4096;
  if (map == 1) {
#pragma unroll
    for (int d0 = 0; d0 < 4; ++d0)
#pragma unroll
      for (int r = 0; r < 16; ++r) X[(d0 * 16 + r) * 64 + lane] = o[d0][r] * rli[r];
  }
  __syncthreads();
  if (map == 0) {
#pragma unroll
    for (int d0 = 0; d0 < 4; ++d0)
#pragma unroll
      for (int r = 0; r < 16; ++r) o[d0][r] = o[d0][r] * rli[r] + X[(d0 * 16 + r) * 64 + lane];
    float g4[4];
#pragma unroll
    for (int d0 = 0; d0 < 4; ++d0) g4[d0] = ((const GAS float*)gsub)[d0 * 32 + r32] * outscale;
#pragma unroll
    for (int r = 0; r < 16; ++r) { float ss = (o[0][r] * o[0][r] + o[1][r] * o[1][r]) + (o[2][r] * o[2][r] + o[3][r] * o[3][r]);
      ss = xadd<1>(ss); ss = xadd<2>(ss); ss = xadd<4>(ss); ss = xadd<8>(ss); ss = xadd<16>(ss);
      rli[r] = rsqrtf(ss * (1.f / 128.f) + 1e-5f); }
    asm volatile("s_waitcnt lgkmcnt(0)" ::: "memory");
    bf16* stg = (bf16*)(lds + wq * 16384);
#pragma unroll
    for (int r = 0; r < 16; ++r) { const int orow = crow(r, hi);
#pragma unroll
      for (int d0 = 0; d0 < 4; ++d0) stg[orow * 128 + d0 * 32 + r32] = __float2bfloat16(o[d0][r] * rli[r] * g4[d0]); }
    asm volatile("s_waitcnt lgkmcnt(0)" ::: "memory");
    bf16* Ow = Ob + (long)(wq * QBLK) * 1024;
#pragma unroll
    for (int i = 0; i < 8; ++i) { const int row = i * 4 + (lane >> 4), ch = lane & 15; const u32x4 v = *(const u32x4*)(stg + row * 128 + ch * 8); *(GAS u32x4*)(Ow + (long)row * 1024 + ch * 8) = v; }
  }
  __syncthreads();
#undef SLOAD
#undef SWRITE
#undef RESC
}
#undef SBAR
}
constexpr int NWAVES = 8;
constexpr int SEQ = 2048, NBATCH = 32, M = NBATCH * SEQ, DM = 1024, PIN = 2080, PINP = 2304, FF = 4096, NLAYER = 2;
constexpr size_t MiB = 1u << 20;
constexpr size_t WS_SSQ = 0, WS_CS = 4 * MiB, WS_WIN = 5 * MiB, WS_WUQ = 14 * MiB, WS_WUKV = 15 * MiB, WS_WOUT = 16 * MiB, WS_WUP = 20 * MiB, WS_WDN = 36 * MiB;
constexpr size_t WS_HB = 52 * MiB, WS_CQ = 180 * MiB, WS_CKV = 212 * MiB, WS_DQ = 244 * MiB, WS_DK = 308 * MiB, WS_DV = 372 * MiB, WS_KR = 436 * MiB, WS_Q = 440 * MiB, WS_KV = 536 * MiB, WS_O = 664 * MiB;
static_assert(WS_CQ == pg8::ZO_CQ && WS_CKV == WS_CQ + pg8::ZS_CQ && WS_DQ == pg8::ZO_DQ && WS_DK == WS_DQ + pg8::ZS_DQ && WS_DV == WS_DK + pg8::ZS_DQ && WS_KR == pg8::ZO_KR, "EpiZ offsets");
constexpr size_t WS_HID = 180 * MiB, WS_SSQP = 792 * MiB, WS_END = 828 * MiB;
constexpr int LDS_BYTES = 147456, PARAMS_OFF = 135168, XB_LDS_OFF = 135168 + 512;
constexpr size_t WS_BAR = 0, BAR_BYTES = 32768;
#define LAS __attribute__((address_space(3)))
typedef unsigned short bf16;
typedef unsigned v4u __attribute__((ext_vector_type(4)));
typedef unsigned v2u __attribute__((ext_vector_type(2)));
typedef float f32x4 __attribute__((ext_vector_type(4)));
#define RLX_AGENT __ATOMIC_RELAXED, __HIP_MEMORY_SCOPE_AGENT
#define XB_TMO      128
#define XB_XCNT(j)  (256  + 64 * (j))
#define XB_XSUB(j)  (1280 + 64 * (j))
#define XB_XGEN(j)  (2304 + 64 * (j))
#define XB_TOP      3328
#define XB_TOPGEN   3392
#define XCD_BAR_WORDS 3456
#define XB_SPIN_CAP (1u << 18)

__device__ __forceinline__ unsigned xb_ld(unsigned* p)              { return __hip_atomic_load(p, __ATOMIC_RELAXED, __HIP_MEMORY_SCOPE_AGENT); }
__device__ __forceinline__ unsigned xb_add(unsigned* p, unsigned v) { return __hip_atomic_fetch_add(p, v, __ATOMIC_RELAXED, __HIP_MEMORY_SCOPE_AGENT); }
__device__ __forceinline__ unsigned xb_xcc_id() { return (unsigned)__builtin_amdgcn_s_getreg((3 << 11) | 20) & 0xFu; }
#define XB_SPIN(cond, bar) do { unsigned _sp = 0; while (cond) { __builtin_amdgcn_s_sleep(1); \
    if ((++_sp & 255u) == 0u) { if (xb_ld(&(bar)[XB_TMO])) break; if (_sp > XB_SPIN_CAP) { atomicAdd(&(bar)[XB_TMO], 1u); break; } } } } while (0)

struct XcdBarrier {
    unsigned* bar; unsigned x;
    volatile LAS unsigned* st;
};

__device__ __forceinline__ XcdBarrier xcd_barrier_post(unsigned* bar, volatile LAS unsigned* st) {
    XcdBarrier b; b.bar = bar; b.x = xb_xcc_id(); b.st = st;
    if (threadIdx.x == 0) st[2] = xb_add(&bar[XB_XCNT(b.x)], 1u);
    return b;
}
__device__ __forceinline__ void xcd_barrier_complete(unsigned* bar, unsigned x, unsigned& nloc, unsigned& nx) {
    const unsigned G = gridDim.x * gridDim.y * gridDim.z;
    unsigned sum, cnt, mine, sp = 0u;
    for (;;) {
        sum = 0u; cnt = 0u; mine = 0u;
#pragma unroll
        for (unsigned j = 0; j < 16; ++j) { const unsigned c = xb_ld(&bar[XB_XCNT(j)]); sum += c; cnt += (c > 0u) ? 1u : 0u; mine = (j == x) ? c : mine; }
        if (sum == G) break;
        __builtin_amdgcn_s_sleep(1);
        if ((++sp & 255u) == 0u) { if (xb_ld(&bar[XB_TMO])) break; if (sp > XB_SPIN_CAP) { atomicAdd(&bar[XB_TMO], 1u); break; } }
    }
    nloc = mine > 0u ? mine : 1u; nx = cnt > 0u ? cnt : 1u;
}

__device__ __forceinline__ void xcd_barrier(const XcdBarrier& b) {
    asm volatile("s_waitcnt vmcnt(0)" ::: "memory");
    __syncthreads();
    if (threadIdx.x == 0) {
        unsigned* bar = b.bar;
        __builtin_amdgcn_s_waitcnt(0);
        unsigned nloc = b.st[0], nx = b.st[1];
        if (nloc == 0u) { xcd_barrier_complete(bar, b.x, nloc, nx); b.st[0] = nloc; b.st[1] = nx; }
        const unsigned old = xb_add(&bar[XB_XSUB(b.x)], 1u);
        const unsigned gen = old / nloc;
        if (old + 1u == (gen + 1u) * nloc) {
            __builtin_amdgcn_fence(__ATOMIC_RELEASE, "agent");
            asm volatile("s_waitcnt vmcnt(0)" ::: "memory");
            const unsigned og = xb_add(&bar[XB_TOP], 1u);
            const unsigned tg = og / nx;
            if (og + 1u == (tg + 1u) * nx) xb_add(&bar[XB_TOPGEN], 1u);
            else XB_SPIN(xb_ld(&bar[XB_TOPGEN]) == tg, bar);
            __builtin_amdgcn_fence(__ATOMIC_ACQUIRE, "agent");
            xb_add(&bar[XB_XGEN(b.x)], 1u);
            asm volatile("s_waitcnt vmcnt(0)" ::: "memory");
        } else {
            XB_SPIN(xb_ld(&bar[XB_XGEN(b.x)]) == gen, bar);
            __builtin_amdgcn_fence(__ATOMIC_ACQUIRE, "agent");
            asm volatile("s_waitcnt vmcnt(0)" ::: "memory");
        }
    }
    __syncthreads();
}

#define XL_SUB(j) (4096 + 64 * (j))
#define XL_GEN(j) (5120 + 64 * (j))
__device__ __forceinline__ void xcd_local_barrier(const XcdBarrier& b, unsigned target) {
    asm volatile("s_waitcnt vmcnt(0)" ::: "memory");
    __syncthreads();
    if (threadIdx.x == 0) {
        unsigned* bar = b.bar;
        (void)xb_add(&bar[XL_SUB(b.x)], 1u);
        XB_SPIN(xb_ld(&bar[XL_SUB(b.x)]) < target, bar);
        __builtin_amdgcn_fence(__ATOMIC_ACQUIRE, "agent");
        asm volatile("s_waitcnt vmcnt(0)" ::: "memory");
    }
    __syncthreads();
}
__device__ __forceinline__ unsigned xcd_census_uniform(unsigned* bar, unsigned G) {
    unsigned pop = 0u, bad = 0u;
#pragma unroll
    for (unsigned j = 0; j < 16; ++j) { const unsigned c = xb_ld(&bar[XB_XCNT(j)]); pop += (c != 0u) ? 1u : 0u; bad |= (c != 0u && c * 8u != G) ? 1u : 0u; }
    return (pop == 8u && bad == 0u) ? 1u : 0u;
}
__device__ __forceinline__ unsigned pk2(float lo, float hi) { return pg8::cvt_pk_bf16(lo, hi); }
__device__ __forceinline__ float wave_sum(float v) {
    v = xadd<1>(v); v = xadd<2>(v); v = xadd<4>(v); v = xadd<8>(v); v = xadd<16>(v); v = xadd<32>(v);
    return v;
}
__device__ __forceinline__ void tr_item(const float* __restrict__ W, int N, int src_n0, int k0, int K, bf16* __restrict__ WTrow0, const float* __restrict__ gain, bool zero, bool perm, LAS float* scr, int lane) {
    const int s_ = lane & 31, col = perm ? (8 * ((s_ >> 2) & 3) + 4 * (s_ >> 4) + (s_ & 3)) : s_;
#pragma unroll
    for (int i = 0; i < 32; ++i) { const int kk = 2 * i + (lane >> 5); float v = 0.f;
        if (!zero) { v = ((const GAS float*)W)[(size_t)(k0 + kk) * N + src_n0 + (lane & 31)]; if (gain) v *= ((const GAS float*)gain)[k0 + kk]; }
        scr[kk * 33 + col] = v; }
    asm volatile("s_waitcnt lgkmcnt(0)" ::: "memory");
    const int c = lane & 7;
#pragma unroll
    for (int j = 0; j < 4; ++j) { const int n = (lane >> 3) + 8 * j; const LAS float* s = scr + (8 * c) * 33 + n;
        v4u o; o.x = pk2(s[0 * 33], s[1 * 33]); o.y = pk2(s[2 * 33], s[3 * 33]); o.z = pk2(s[4 * 33], s[5 * 33]); o.w = pk2(s[6 * 33], s[7 * 33]);
        *(GAS v4u*)(WTrow0 + (size_t)n * K + k0 + 8 * c) = o; }
    asm volatile("s_waitcnt lgkmcnt(0)" ::: "memory");
}
__device__ __forceinline__ const void* ldptr(const LAS void* q) { const LAS unsigned* w = (const LAS unsigned*)q; const unsigned lo = __builtin_amdgcn_readfirstlane(w[0]), hi = __builtin_amdgcn_readfirstlane(w[1]); return (const void*)(((unsigned long long)hi << 32) | lo); }
struct Params { const float* in[17]; float* out; unsigned char* ws; int ph_lo, ph_hi; float lam_init0, lam_init1; };
enum { I_X = 0, I_WIN, I_GMIX, I_GQ, I_GKV, I_WUQ, I_WUKV, I_LQ1, I_LK1, I_LQ2, I_LK2, I_GSUB, I_WOUT, I_GMLP, I_WUP, I_WDN, I_GFIN };
constexpr int N_PHASES = 14;
#ifndef REP_Z
#define REP_Z 1
#endif
#ifndef REP_UP
#define REP_UP 1
#endif
#ifndef REP_MLA
#define REP_MLA 1
#endif
#ifndef REP_DIFF
#define REP_DIFF 1
#endif
#ifndef PHM
#define PHM 127
#endif

__global__ void __launch_bounds__(NWAVES * 64, 2) fwd_mega(Params p) {
    extern __shared__ __attribute__((aligned(16))) unsigned char lds[];
    cg::grid_group grid = cg::this_grid();
    LAS unsigned char* ldsl = (LAS unsigned char*)lds;
    const int wv = __builtin_amdgcn_readfirstlane(threadIdx.x >> 6);
    const int G0 = gridDim.x, bx0 = blockIdx.x;
    if (threadIdx.x == 0) { LAS unsigned long long* w = (LAS unsigned long long*)(ldsl + PARAMS_OFF);
#pragma unroll
        for (int i = 0; i < 17; ++i) w[i] = (unsigned long long)(uintptr_t)p.in[i];
        w[17] = (unsigned long long)(uintptr_t)p.out; w[18] = (unsigned long long)(uintptr_t)p.ws;
        LAS float* wf = (LAS float*)(ldsl + PARAMS_OFF); wf[40] = p.lam_init0; wf[41] = p.lam_init1; }
    static_assert(offsetof(Params, out) == 136 && offsetof(Params, ws) == 144 && offsetof(Params, lam_init0) == 160 && offsetof(Params, lam_init1) == 164, "Params layout");
    __syncthreads();
    if (threadIdx.x < 4) ((LAS unsigned*)(ldsl + XB_LDS_OFF))[threadIdx.x] = 0u;
    __syncthreads();
    const XcdBarrier xbar = xcd_barrier_post((unsigned*)(p.ws + WS_BAR), (volatile LAS unsigned*)(ldsl + XB_LDS_OFF));
    const int ph_lo = __builtin_amdgcn_readfirstlane(p.ph_lo), ph_hi = __builtin_amdgcn_readfirstlane(p.ph_hi);
#define PIN_(k) ((const float*)ldptr(&PL->in[k]))

    unsigned n_local = 0u;
    for (int ph = ph_lo; ph < ph_hi; ++ph) {
        if (ph > ph_lo) {
            volatile LAS unsigned* xst = (volatile LAS unsigned*)(ldsl + XB_LDS_OFF);
            if (ph == ph_lo + 1) { grid.sync();
                if (threadIdx.x == 0) xst[3] = xcd_census_uniform(xbar.bar, (unsigned)G0);
                __syncthreads(); }
            else if (ph == N_PHASES - 1 || (ph - 1) % 6 == 4 || (ph - 1) % 6 == 0 || __builtin_amdgcn_readfirstlane(xst[3]) == 0u) xcd_barrier(xbar);
            else { n_local += (unsigned)G0 >> 3; xcd_local_barrier(xbar, n_local); }
        }
        int po = PARAMS_OFF, G = G0, bx = bx0;
        if (ph > ph_lo) { volatile LAS unsigned* xst = (volatile LAS unsigned*)(ldsl + XB_LDS_OFF);
            if (__builtin_amdgcn_readfirstlane(xst[3]) != 0u) bx = (int)(__builtin_amdgcn_readfirstlane(xst[2]) * 8u + xbar.x); }
        asm volatile("" : "+s"(po), "+s"(G), "+s"(bx));
        const int vcu = (G % 8 == 0) ? (bx % 8) * (G / 8) + bx / 8 : bx;
        const LAS Params* PL = (const LAS Params*)(ldsl + po);
        unsigned char* ws = (unsigned char*)ldptr(&PL->ws); float* out = (float*)ldptr(&PL->out);
        float* ssq = (float*)(ws + WS_SSQP); float* cs = (float*)(ws + WS_CS);
        bf16* HB = (bf16*)(ws + WS_HB); bf16* CQ = (bf16*)(ws + WS_CQ); bf16* CKV = (bf16*)(ws + WS_CKV); bf16* DQ = (bf16*)(ws + WS_DQ); bf16* DK = (bf16*)(ws + WS_DK); bf16* DV = (bf16*)(ws + WS_DV);
        bf16* KR = (bf16*)(ws + WS_KR); bf16* Qm = (bf16*)(ws + WS_Q); bf16* KV = (bf16*)(ws + WS_KV); bf16* Ob = (bf16*)(ws + WS_O); bf16* HID = (bf16*)(ws + WS_HID);

        if (ph == 0 && (PHM & 1)) {
            int tid; asm volatile("v_mbcnt_lo_u32_b32 %0, -1, 0\n\tv_mbcnt_hi_u32_b32 %0, -1, %0" : "=v"(tid)); tid += wv * 64; const int lane = tid & 63, wave = __builtin_amdgcn_readfirstlane(tid >> 6);
            const int gw = vcu * NWAVES + wave, NGW = G * NWAVES, gt = bx * (NWAVES * 64) + tid, GT = G * NWAVES * 64;
            for (int i = gt; i < SEQ * 16; i += GT) { const int pos = i >> 4, f = i & 15; const float inv = exp2f(-(float)f * (13.287712379549449f / 16.f));
                const float ang = (float)pos * inv; double rev = (double)ang * 0.15915494309189535; rev -= floor(rev); const float fr = (float)rev;
                ((GAS float*)cs)[pos * 32 + f] = __builtin_amdgcn_cosf(fr); ((GAS float*)cs)[pos * 32 + 16 + f] = __builtin_amdgcn_sinf(fr); }
            LAS float* scr = (LAS float*)(ldsl + wave * 16384);
            constexpr int I_IN = 16 * 72, I_UQ = 4 * 24, I_UKV = 4 * 32, I_OUT = 16 * 32, I_UP = 16 * 128, I_DN = 64 * 32, I_L = I_IN + I_UQ + I_UKV + I_OUT + I_UP + I_DN;
            for (int it = gw; it < NLAYER * I_L; it += NGW) {
                const int l = it / I_L; int r = it % I_L;
                if (r < I_IN) { const int kb = r / 72, nb = r % 72, n0 = 32 * nb; const bool zero = n0 > 2048; const int src = n0 < 512 ? n0 : (n0 < 2048 ? n0 + 32 : 512);
                    tr_item(PIN_(I_WIN) + (size_t)l * DM * PIN, PIN, src, 64 * kb, DM, (bf16*)(ws + WS_WIN) + ((size_t)l * PINP + n0) * DM, PIN_(I_GMIX) + l * DM, zero, n0 == 2048, scr, lane); continue; } r -= I_IN;
                if (r < I_UQ) { const int kb = r / 24, nb = r % 24;
                    tr_item(PIN_(I_WUQ) + (size_t)l * 256 * 768, 768, 32 * nb, 64 * kb, 256, (bf16*)(ws + WS_WUQ) + ((size_t)l * 768 + 32 * nb) * 256, PIN_(I_GQ) + l * 256, false, (nb % 3) == 2, scr, lane); continue; } r -= I_UQ;
                if (r < I_UKV) { const int kb = r / 32, nb = r % 32;
                    tr_item(PIN_(I_WUKV) + (size_t)l * 256 * 1024, 1024, 32 * nb, 64 * kb, 256, (bf16*)(ws + WS_WUKV) + ((size_t)l * 1024 + 32 * nb) * 256, PIN_(I_GKV) + l * 256, false, false, scr, lane); continue; } r -= I_UKV;
                if (r < I_OUT) { const int kb = r / 32, nb = r % 32;
                    tr_item(PIN_(I_WOUT) + (size_t)l * 1024 * 1024, 1024, 32 * nb, 64 * kb, 1024, (bf16*)(ws + WS_WOUT) + ((size_t)l * 1024 + 32 * nb) * 1024, nullptr, false, false, scr, lane); continue; } r -= I_OUT;
                if (r < I_UP) { const int kb = r / 128, nb = r % 128;
                    tr_item(PIN_(I_WUP) + (size_t)l * 1024 * FF, FF, 32 * nb, 64 * kb, 1024, (bf16*)(ws + WS_WUP) + ((size_t)l * FF + 32 * nb) * 1024, PIN_(I_GMLP) + l * DM, false, false, scr, lane); continue; } r -= I_UP;
                { const int kb = r / 32, nb = r % 32;
                    tr_item(PIN_(I_WDN) + (size_t)l * FF * 1024, 1024, 32 * nb, 64 * kb, FF, (bf16*)(ws + WS_WDN) + ((size_t)l * 1024 + 32 * nb) * FF, nullptr, false, false, scr, lane); }
            }
            const float* x = PIN_(I_X);
            for (int row0 = gw * 4; row0 < M; row0 += NGW * 4) {
                f32x4 v[4][4]; float s[4];
#pragma unroll
                for (int q = 0; q < 4; ++q) { const GAS f32x4* xr = (const GAS f32x4*)(x + (size_t)(row0 + q) * DM) + lane;
#pragma unroll
                    for (int j = 0; j < 4; ++j) v[q][j] = xr[64 * j]; }
#pragma unroll
                for (int q = 0; q < 4; ++q) { s[q] = 0.f;
#pragma unroll
                    for (int j = 0; j < 4; ++j) s[q] += pg8::dot4(v[q][j]);
                    s[q] = wave_sum(s[q]);
                    GAS v2u* o8 = (GAS v2u*)(HB + (size_t)(row0 + q) * DM) + lane;
#pragma unroll
                    for (int j = 0; j < 4; ++j) { v2u w; w.x = pk2(v[q][j][0], v[q][j][1]); w.y = pk2(v[q][j][2], v[q][j][3]); o8[64 * j] = w; }
                    if (lane < 16) ((GAS float*)ssq)[(size_t)(row0 + q) * 16 + lane] = lane == 0 ? s[q] : 0.f; }
            }
        } else if (ph == N_PHASES - 1 && (PHM & 2)) {
            int tid; asm volatile("v_mbcnt_lo_u32_b32 %0, -1, 0\n\tv_mbcnt_hi_u32_b32 %0, -1, %0" : "=v"(tid)); tid += wv * 64; const int lane = tid & 63, wave = __builtin_amdgcn_readfirstlane(tid >> 6);
            const int gw = vcu * NWAVES + wave, NGW = G * NWAVES; const float* gf = PIN_(I_GFIN); const float* sq = ssq + (size_t)8 * pg8::SSQ_ARR;
            f32x4 gv[4];
#pragma unroll
            for (int j = 0; j < 4; ++j) gv[j] = ((const GAS f32x4*)gf)[lane + 64 * j];
            for (int row0 = gw * 4; row0 < M; row0 += NGW * 4) {
                v2u w[4][4]; float rs[4];
#pragma unroll
                for (int q = 0; q < 4; ++q) { const GAS v2u* hr = (const GAS v2u*)(HB + (size_t)(row0 + q) * DM) + lane;
#pragma unroll
                    for (int j = 0; j < 4; ++j) w[q][j] = hr[64 * j];
                    rs[q] = rsqrtf(pg8::ssq16(sq + (size_t)(row0 + q) * 16) * (1.f / 1024.f) + 1e-6f); }
#pragma unroll
                for (int q = 0; q < 4; ++q) { GAS f32x4* xr = (GAS f32x4*)(out + (size_t)(row0 + q) * DM) + lane;
#pragma unroll
                    for (int j = 0; j < 4; ++j) { const f32x4 h = {__uint_as_float(w[q][j].x << 16), __uint_as_float(w[q][j].x & 0xffff0000u), __uint_as_float(w[q][j].y << 16), __uint_as_float(w[q][j].y & 0xffff0000u)};
                        xr[64 * j] = h * rs[q] * gv[j]; } }
            }
        } else {
            const int l = (ph - 1) / 6, k = (ph - 1) % 6;
            float* sq_in = ssq + (size_t)(4 * l) * pg8::SSQ_ARR; float* sq_q = sq_in + pg8::SSQ_ARR; float* sq_kv = sq_in + 2 * pg8::SSQ_ARR; float* sq_mid = sq_in + 3 * pg8::SSQ_ARR; float* sq_out = sq_in + 4 * pg8::SSQ_ARR;
            if (k == 0 && (PHM & 4)) {
                for (int rep = 0; rep < REP_Z; ++rep) {
                pg8::Gemm g{HB, (bf16*)(ws + WS_WIN) + (size_t)l * PINP * DM, M, PINP, DM}; pg8::StaticOrder S; S.init(M, PINP, G, bx);
                pg8::EpiZ E{sq_in, sq_q, ws, cs};
                pg8::gemm_phase<pg8::EpiZ, pg8::StaticOrder, true, true>(ldsl, g, S, E, wv); }
            } else if (k == 1 && (PHM & 8)) {
                { pg8::Gemm g{CQ, (bf16*)(ws + WS_WUQ) + (size_t)l * 768 * 256, M, 768, 256}; pg8::StaticOrder S; S.init(M, 768, G, bx);
                  pg8::EpiQ E{sq_q, Qm, cs};
                  pg8::gemm_phase<pg8::EpiQ, pg8::StaticOrder, true, true>(ldsl, g, S, E, wv); }
                { pg8::Gemm g{CKV, (bf16*)(ws + WS_WUKV) + (size_t)l * 1024 * 256, M, 1024, 256}; pg8::StaticOrder S; S.init(M, 1024, G, bx);
                  pg8::EpiRow<0, 4> E{sq_kv, 1.f / 256.f, KV, 1024};
                  pg8::gemm_phase<pg8::EpiRow<0, 4>, pg8::StaticOrder, true, true>(ldsl, g, S, E, wv); }
            } else if (k == 2 && (PHM & 16)) {
                const int NU = 2048;
                for (int rep = 0; rep < REP_MLA; ++rep) for (int i = 0; i * G + vcu < NU; ++i) {
                    int bh, qb; if (G == 256) { bh = (vcu >> 3) * 8 + i; qb = vcu & 7; } else { const int u = i * G + vcu; bh = u >> 3; qb = u & 7; }
                    const int b = bh >> 3, h = bh & 7; const size_t r0 = (size_t)b * SEQ;
                    att::mla_unit((const att::bf16*)Qm + (r0 + qb * 256) * 768 + h * 96, (const att::bf16*)KV + r0 * 1024 + h * 128, (const att::bf16*)KR + r0 * 32,
                                  (att::bf16*)Ob + (r0 + qb * 256) * 1024 + h * 64, (char*)lds, wv);
                }
                float lam;
                int tid; asm volatile("v_mbcnt_lo_u32_b32 %0, -1, 0\n\tv_mbcnt_hi_u32_b32 %0, -1, %0" : "=v"(tid)); tid += wv * 64; const int lane = tid & 63;
                { const float a = ((const GAS float*)PIN_(I_LQ1))[l * 64 + lane] * ((const GAS float*)PIN_(I_LK1))[l * 64 + lane], b = ((const GAS float*)PIN_(I_LQ2))[l * 64 + lane] * ((const GAS float*)PIN_(I_LK2))[l * 64 + lane];
                  lam = expf(wave_sum(a)) - expf(wave_sum(b)) + (l == 0 ? PL->lam_init0 : PL->lam_init1); lam = __uint_as_float(__builtin_amdgcn_readfirstlane(__float_as_uint(lam))); }
                const float outscale = __uint_as_float(__builtin_amdgcn_readfirstlane(__float_as_uint(1.f - (l == 0 ? PL->lam_init0 : PL->lam_init1))));
                for (int rep = 0; rep < REP_DIFF; ++rep) for (int i = 0; i * G + vcu < NU; ++i) {
                    int bh, qb; if (G == 256) { bh = (vcu >> 3) * 4 + (i >> 1); qb = (i & 1) * 8 + (vcu & 7); } else { const int u = i * G + vcu; bh = u >> 4; qb = u & 15; }
                    const int b = bh >> 2, h = bh & 3; const size_t r0 = (size_t)b * SEQ;
                    const float nslope2 = -exp2f(-2.f * (float)(h + 1)) * K_LOG2E;
                    att::diff_unit((const att::bf16*)DQ + (r0 + qb * 128) * 512 + h * 128, (const att::bf16*)DK + r0 * 512 + h * 128, (const att::bf16*)DV + r0 * 512 + h * 128,
                                   (att::bf16*)Ob + (r0 + qb * 128) * 1024 + 512 + h * 128, qb * 128, nslope2, lam, PIN_(I_GSUB) + l * 128, outscale, (char*)lds, wv);
                }
            } else if ((k == 3 || k == 5) && (PHM & 32)) {
                const bool dn = (k == 5);
                pg8::Gemm g{dn ? HID : Ob, dn ? (bf16*)(ws + WS_WDN) + (size_t)l * 1024 * FF : (bf16*)(ws + WS_WOUT) + (size_t)l * 1024 * 1024, M, 1024, dn ? FF : 1024};
                pg8::StaticOrder S; S.init(M, 1024, G, bx);
                pg8::EpiRes E{HB, dn ? sq_out : sq_mid};
                pg8::gemm_phase<pg8::EpiRes, pg8::StaticOrder, true, true>(ldsl, g, S, E, wv);
            } else if (PHM & 64) {
                for (int rep = 0; rep < REP_UP; ++rep) {
                pg8::Gemm g{HB, (bf16*)(ws + WS_WUP) + (size_t)l * FF * 1024, M, FF, 1024}; pg8::StaticOrder S; S.init(M, FF, G, bx);
                pg8::EpiRow<1, 16> E{sq_mid, 1.f / 1024.f, HID, FF};
                pg8::gemm_phase<pg8::EpiRow<1, 16>, pg8::StaticOrder, true, true>(ldsl, g, S, E, wv); }
            }
        }
    }
}

extern "C" void kernel_launch(void* const* d_in, const int* in_sizes, int n_in, void* d_out, int out_size, void* d_ws, size_t ws_size, hipStream_t stream) {
    static int grid = 0;
    if (grid == 0) {
        if (n_in != 17 || in_sizes[0] != M * DM || out_size != M * DM || ws_size < WS_END) { fprintf(stderr, "kernel_launch: shape/workspace mismatch (n_in %d, ws %zu)\n", n_in, ws_size); grid = -1; return; }
        int dev = 0, cus = 0, per_cu = 0;
        hipGetDevice(&dev); hipDeviceGetAttribute(&cus, hipDeviceAttributeMultiprocessorCount, dev);
        if (hipFuncSetAttribute((const void*)fwd_mega, hipFuncAttributeMaxDynamicSharedMemorySize, LDS_BYTES) != hipSuccess) { fprintf(stderr, "kernel_launch: hipFuncSetAttribute failed\n"); grid = -1; return; }
        if (hipOccupancyMaxActiveBlocksPerMultiprocessor(&per_cu, (const void*)fwd_mega, NWAVES * 64, LDS_BYTES) != hipSuccess || per_cu < 1) per_cu = 1;
        (void)hipGetLastError();
        grid = cus * per_cu;
    }
    if (grid < 0) return;
    if (hipMemsetAsync((char*)d_ws + WS_BAR, 0, BAR_BYTES, stream) != hipSuccess) { fprintf(stderr, "kernel_launch: memset of the barrier words failed\n"); return; }
    Params p{};
    for (int i = 0; i < 17; ++i) p.in[i] = (const float*)d_in[i];
    p.out = (float*)d_out; p.ws = (unsigned char*)d_ws; p.ph_lo = 0; p.ph_hi = N_PHASES;
    p.lam_init0 = (float)(0.8 - 0.6 * exp(-0.3 * 0.0)); p.lam_init1 = (float)(0.8 - 0.6 * exp(-0.3 * 1.0));
    void* args[] = {&p};
    hipError_t e = hipLaunchCooperativeKernel((void*)fwd_mega, dim3(grid), dim3(NWAVES * 64), args, LDS_BYTES, stream);
    if (e != hipSuccess) fprintf(stderr, "kernel_launch: cooperative launch failed: %s (grid %d)\n", hipGetErrorString(e), grid);
}
```

```cpp
#include <hip/hip_runtime.h>
#include <hip/hip_bf16.h>
#include <hip/hip_cooperative_groups.h>
#include <cstdio>
#include <cstdint>
#include <cmath>
namespace cg = cooperative_groups;
#define GAS __attribute__((address_space(1)))
constexpr float K_LOG2E = 1.4426950408889634f;
constexpr float K_C2M = 0.10206207261596575f * K_LOG2E;
constexpr float K_C2D = 0.125f * K_LOG2E;
template <int MASK> __device__ __forceinline__ float xadd(float v) {
    if constexpr (MASK == 32) { auto rr = __builtin_amdgcn_permlane32_swap(__float_as_uint(v), __float_as_uint(v), false, false); return __uint_as_float(rr[0]) + __uint_as_float(rr[1]); }
    else return v + __int_as_float(__builtin_amdgcn_ds_swizzle(__float_as_int(v), 0x1F | (MASK << 10)));
}
namespace pg8 {
#define PG8_LAS __attribute__((address_space(3)))
typedef unsigned short bf16_t;
typedef short bf16x8 __attribute__((ext_vector_type(8)));
typedef float f32x4 __attribute__((ext_vector_type(4)));
typedef unsigned u32x4 __attribute__((ext_vector_type(4)));
constexpr int BM = 256, BK = 64, HALF = 128, HTB = HALF * BK * 2  , STAGE_BYTES = 8 * HTB, NXCD = 8, WGM = 8;

__host__ __device__ __forceinline__ int lds_byte(int r, int c) { const int st = (r >> 4) * 2 + (c >> 5), rr = r & 15, cc = c & 31, ob = rr * 64 + cc * 2; return st * 1024 + (ob ^ (((ob >> 9) & 1) << 5)); }
__host__ __device__ __forceinline__ void stage_rc(int b, int& R, int& C) { const int st = b / 1024, sb = b % 1024, swz = sb ^ (((sb >> 9) & 1) << 5); R = (st >> 1) * 16 + swz / 64; C = (st & 1) * 32 + (swz % 64) / 2; }
__host__ __device__ __forceinline__ int perm32(int rho) { const int n = rho >> 4, i = rho & 15; return 8 * (i >> 2) + 4 * n + (i & 3); }

struct Unit { int pm, pn; };
struct Gemm { const bf16_t* A; const bf16_t* Bt; int M, N, K; };

struct StaticOrder {
    int nM, nN, nwg, G, c;
    __host__ __device__ void init(int M, int N, int G_, int c_) { nM = M / BM; nN = N / BM; nwg = nM * nN; G = G_; c = c_; }
    __host__ __device__ bool next(int i, Unit& u) const {
        const long L = (long)i * G + c; if (L >= nwg) return false;
        int wgid = (int)L; { const int q = nwg / NXCD, r = nwg % NXCD, xcd = wgid % NXCD, off = wgid / NXCD; wgid = (xcd < r ? xcd * (q + 1) : r * (q + 1) + (xcd - r) * q) + off; }
        const int nig = WGM * nN, gid = wgid / nig, fm = gid * WGM, gsz = (nM - fm) < WGM ? (nM - fm) : WGM;
        u.pm = fm + ((wgid % nig) % gsz); u.pn = (wgid % nig) / gsz; return true;
    }
    __device__ __forceinline__ void a_ready(const Unit&) const {}
    __device__ __forceinline__ void done(const Unit&) const {}
};
__device__ __forceinline__ unsigned cvt_pk_bf16(float lo, float hi) { unsigned r; asm volatile("v_cvt_pk_bf16_f32 %0, %1, %2" : "=v"(r) : "v"(lo), "v"(hi)); return r; }
typedef float f32x2 __attribute__((ext_vector_type(2)));
typedef unsigned u32x2 __attribute__((ext_vector_type(2)));
__device__ __forceinline__ float dot4(f32x4 v) { return (v[0] * v[0] + v[1] * v[1]) + (v[2] * v[2] + v[3] * v[3]); }
__device__ __forceinline__ void st4bf(bf16_t* p, f32x4 v) { u32x2 w; w.x = cvt_pk_bf16(v[0], v[1]); w.y = cvt_pk_bf16(v[2], v[3]); *(GAS u32x2*)p = w; }
__device__ __forceinline__ void st8bf(bf16_t* p, f32x4 v0, f32x4 v1) { u32x4 w; w.x = cvt_pk_bf16(v0[0], v0[1]); w.y = cvt_pk_bf16(v0[2], v0[3]); w.z = cvt_pk_bf16(v1[0], v1[1]); w.w = cvt_pk_bf16(v1[2], v1[3]); *(GAS u32x4*)p = w; }
__device__ __forceinline__ float ssq16(const float* p) { const f32x4 a = *(const GAS f32x4*)p, b = *(const GAS f32x4*)(p + 4), c = *(const GAS f32x4*)(p + 8), d = *(const GAS f32x4*)(p + 12);
    return (((a[0] + a[1]) + (a[2] + a[3])) + ((b[0] + b[1]) + (b[2] + b[3]))) + (((c[0] + c[1]) + (c[2] + c[3])) + ((d[0] + d[1]) + (d[2] + d[3]))); }
__device__ __forceinline__ float ssq16q(const float* p, int fq) { const f32x4 a = *(const GAS f32x4*)(p + 4 * fq); float s = (a[0] + a[1]) + (a[2] + a[3]); s = xadd<16>(s); return xadd<32>(s); }
__device__ __forceinline__ float ssq4(const float* p) { const f32x4 a = *(const GAS f32x4*)p; return (a[0] + a[1]) + (a[2] + a[3]); }
template <int NP> __device__ __forceinline__ void row_scales(float (&rs)[2][4], const float* sq_row0  , int fq, float inv_n) {
#pragma unroll
    for (int ai = 0; ai < 2; ++ai) {
        f32x4 q[4];
#pragma unroll
        for (int m = 0; m < 4; ++m) q[m] = *(const GAS f32x4*)(sq_row0 + (size_t)(ai * HALF + m * 16) * 16 + (NP == 16 ? 4 * fq : 0));
#pragma unroll
        for (int m = 0; m < 4; ++m) { float t = (q[m][0] + q[m][1]) + (q[m][2] + q[m][3]); if (NP == 16) { t = xadd<16>(t); t = xadd<32>(t); } rs[ai][m] = rsqrtf(t * inv_n + 1e-6f); }
    }
}
constexpr size_t SSQ_ARR = (size_t)65536 * 16;
constexpr size_t ZO_CQ = (size_t)180 << 20, ZS_CQ = (size_t)32 << 20, ZO_DQ = (size_t)244 << 20, ZS_DQ = (size_t)64 << 20, ZO_KR = (size_t)436 << 20;
struct EpiZ {
    static constexpr bool PERM = true, AFTER_DRAIN = false;
    const float* ssq_h; float* ssq_q; unsigned char* ws; const float* cs;
    __device__ __forceinline__ void operator()(const f32x4 (&acc)[2][2][4][2], const Unit& u, int wr, int wc, int, int) const {
        int ln_; asm volatile("v_mbcnt_lo_u32_b32 %0, -1, 0\n\tv_mbcnt_hi_u32_b32 %0, -1, %0" : "=v"(ln_)); const int fr = ln_ & 15, fq = ln_ >> 4;
        const int pn = u.pn;
        float rsv[2][4]; row_scales<16>(rsv, ssq_h + (size_t)(u.pm * BM + wr * 64 + fr) * 16, fq, 1.f / 1024.f);
#pragma unroll
        for (int ai = 0; ai < 2; ++ai)
#pragma unroll
            for (int m = 0; m < 4; ++m) {
                const int row = u.pm * BM + ai * HALF + wr * 64 + m * 16 + fr;
                const float rs = rsv[ai][m];
                if (pn <= 1) {
                    bf16_t* dst = (bf16_t*)(ws + ZO_CQ + (size_t)pn * ZS_CQ) + (size_t)row * 256 + wc * 32 + fq * 8; float s = 0.f;
#pragma unroll
                    for (int bj = 0; bj < 2; ++bj) { const f32x4 v0 = acc[ai][bj][m][0] * rs, v1 = acc[ai][bj][m][1] * rs; s += dot4(v0) + dot4(v1); st8bf(dst + bj * HALF, v0, v1); }
                    s = xadd<16>(s); s = xadd<32>(s);
                    if (fq == 0) ((GAS float*)ssq_q)[(size_t)pn * SSQ_ARR + (size_t)row * 16 + wc] = s;
                } else if (pn <= 7) {
                    const int which = (pn - 2) >> 1; bf16_t* base = (bf16_t*)(ws + ZO_DQ + (size_t)which * ZS_DQ); const float sc = which == 0 ? rs * K_C2D : rs;
                    bf16_t* dst = base + (size_t)row * 512 + ((pn - 2) & 1) * 256 + wc * 32 + fq * 8;
#pragma unroll
                    for (int bj = 0; bj < 2; ++bj) st8bf(dst + bj * HALF, acc[ai][bj][m][0] * sc, acc[ai][bj][m][1] * sc);
                } else if (wc == 0) {
                    const f32x4 x1 = acc[ai][0][m][0] * rs, x2 = acc[ai][0][m][1] * rs; const int pos = row & 2047;
                    const f32x4 c = *(const GAS f32x4*)(cs + pos * 32 + fq * 4), s = *(const GAS f32x4*)(cs + pos * 32 + 16 + fq * 4);
                    bf16_t* KR = (bf16_t*)(ws + ZO_KR); st4bf(KR + (size_t)row * 32 + fq * 4, x1 * c - x2 * s); st4bf(KR + (size_t)row * 32 + 16 + fq * 4, x1 * s + x2 * c);
                }
            }
    }
};
struct EpiQ {
    static constexpr bool PERM = true, AFTER_DRAIN = false;
    const float* ssq_q; bf16_t* Q; const float* cs;
    __device__ __forceinline__ void operator()(const f32x4 (&acc)[2][2][4][2], const Unit& u, int wr, int wc, int, int) const {
        int ln_; asm volatile("v_mbcnt_lo_u32_b32 %0, -1, 0\n\tv_mbcnt_hi_u32_b32 %0, -1, %0" : "=v"(ln_)); const int fr = ln_ & 15, fq = ln_ >> 4;
        const int row0 = u.pm * BM + wr * 64 + fr;
        const float* csp = cs + (((u.pm * BM) & 2047) + wr * 64 + fr) * 32 + fq * 4;
        const float* sqp = ssq_q + (size_t)row0 * 16;
        bf16_t* qp = Q + (size_t)row0 * 768 + (8 * u.pn + wc) * 32;
        float rsv[2][4]; row_scales<4>(rsv, sqp, fq, 1.f / 256.f);
        const bool rope0 = ((8 * u.pn + wc) % 3) == 2, rope1 = ((8 * u.pn + 4 + wc) % 3) == 2;
#pragma unroll
        for (int ai = 0; ai < 2; ++ai)
#pragma unroll
            for (int m = 0; m < 4; ++m) {
                const int dr = ai * HALF + m * 16;
                const float rs = rsv[ai][m] * K_C2M;
                if (rope0 || rope1) {
                    const f32x4 c = *(const GAS f32x4*)(csp + dr * 32), s = *(const GAS f32x4*)(csp + dr * 32 + 16);
#pragma unroll
                    for (int bj = 0; bj < 2; ++bj) {
                        f32x4 x1 = acc[ai][bj][m][0] * rs, x2 = acc[ai][bj][m][1] * rs;
                        if (bj == 0 ? rope0 : rope1) { const f32x4 o1 = x1 * c - x2 * s, o2 = x1 * s + x2 * c; x1 = o1; x2 = o2; }
                        if (bj == 0 ? rope0 : rope1) { st4bf(qp + (size_t)dr * 768 + bj * 128 + fq * 4, x1); st4bf(qp + (size_t)dr * 768 + bj * 128 + 16 + fq * 4, x2); }
                        else st8bf(qp + (size_t)dr * 768 + bj * 128 + fq * 8, x1, x2);
                    }
                } else {
#pragma unroll
                    for (int bj = 0; bj < 2; ++bj) st8bf(qp + (size_t)dr * 768 + bj * 128 + fq * 8, acc[ai][bj][m][0] * rs, acc[ai][bj][m][1] * rs);
                }
            }
    }
};
template <int ACT, int NP> struct EpiRow {
    static constexpr bool PERM = true, AFTER_DRAIN = false;
    const float* ssq; float inv_n; bf16_t* O; int ldc;
    __device__ __forceinline__ void operator()(const f32x4 (&acc)[2][2][4][2], const Unit& u, int wr, int wc, int, int) const {
        int ln_; asm volatile("v_mbcnt_lo_u32_b32 %0, -1, 0\n\tv_mbcnt_hi_u32_b32 %0, -1, %0" : "=v"(ln_)); const int fr = ln_ & 15, fq = ln_ >> 4;
        float rsv[2][4]; row_scales<NP>(rsv, ssq + (size_t)(u.pm * BM + wr * 64 + fr) * 16, fq, inv_n);
#pragma unroll
        for (int ai = 0; ai < 2; ++ai)
#pragma unroll
            for (int m = 0; m < 4; ++m) {
                const int row = u.pm * BM + ai * HALF + wr * 64 + m * 16 + fr;
                const float rs = rsv[ai][m];
                bf16_t* dst = O + (size_t)row * ldc + u.pn * BM + wc * 32 + 8 * fq;
#pragma unroll
                for (int bj = 0; bj < 2; ++bj) { f32x4 v0 = acc[ai][bj][m][0] * rs, v1 = acc[ai][bj][m][1] * rs;
                    if (ACT == 1) { v0 = __builtin_elementwise_max(v0, (f32x4){0.f, 0.f, 0.f, 0.f}); v1 = __builtin_elementwise_max(v1, (f32x4){0.f, 0.f, 0.f, 0.f}); v0 = v0 * v0; v1 = v1 * v1; }
                    u32x4 w; w.x = cvt_pk_bf16(v0[0], v0[1]); w.y = cvt_pk_bf16(v0[2], v0[3]); w.z = cvt_pk_bf16(v1[0], v1[1]); w.w = cvt_pk_bf16(v1[2], v1[3]);
                    *(GAS u32x4*)(dst + bj * HALF) = w; }
            }
    }
};
struct EpiRes {
    static constexpr bool PERM = true, AFTER_DRAIN = false;
    bf16_t* hb; float* ssq;
    __device__ __forceinline__ void operator()(const f32x4 (&acc)[2][2][4][2], const Unit& u, int wr, int wc, int, int) const {
        int ln_; asm volatile("v_mbcnt_lo_u32_b32 %0, -1, 0\n\tv_mbcnt_hi_u32_b32 %0, -1, %0" : "=v"(ln_)); const int fr = ln_ & 15, fq = ln_ >> 4;
        bf16_t* hp0 = hb + (size_t)(u.pm * BM + wr * 64 + fr) * 1024 + u.pn * BM + wc * 32 + 8 * fq;
#pragma unroll
        for (int ai = 0; ai < 2; ++ai) {
            u32x4 b[4][2];
#pragma unroll
            for (int m = 0; m < 4; ++m)
#pragma unroll
                for (int bj = 0; bj < 2; ++bj) b[m][bj] = *(const GAS u32x4*)(hp0 + (size_t)(ai * HALF + m * 16) * 1024 + bj * HALF);
#pragma unroll
            for (int m = 0; m < 4; ++m) {
                const int row = u.pm * BM + ai * HALF + wr * 64 + m * 16 + fr; bf16_t* hp = hp0 + (size_t)(ai * HALF + m * 16) * 1024; float s = 0.f;
#pragma unroll
                for (int bj = 0; bj < 2; ++bj) {
                    f32x4 v0 = acc[ai][bj][m][0], v1 = acc[ai][bj][m][1]; const u32x4 bb = b[m][bj];
                    v0[0] += __uint_as_float(bb.x << 16); v0[1] += __uint_as_float(bb.x & 0xffff0000u); v0[2] += __uint_as_float(bb.y << 16); v0[3] += __uint_as_float(bb.y & 0xffff0000u);
                    v1[0] += __uint_as_float(bb.z << 16); v1[1] += __uint_as_float(bb.z & 0xffff0000u); v1[2] += __uint_as_float(bb.w << 16); v1[3] += __uint_as_float(bb.w & 0xffff0000u);
                    s += dot4(v0) + dot4(v1);
                    u32x4 w; w.x = cvt_pk_bf16(v0[0], v0[1]); w.y = cvt_pk_bf16(v0[2], v0[3]); w.z = cvt_pk_bf16(v1[0], v1[1]); w.w = cvt_pk_bf16(v1[2], v1[3]);
                    *(GAS u32x4*)(hp + bj * HALF) = w;
                }
                s = xadd<16>(s); s = xadd<32>(s);
                if (fq == 0) ((GAS float*)ssq)[(size_t)row * 16 + u.pn * 4 + wc] = s;
            }
        }
    }
};
template <class Epi, class Sched, bool ALIGN_EPI = false, bool SP2 = false>
__device__ __forceinline__ void gemm_phase(PG8_LAS unsigned char* lds, const Gemm g, const Sched& S, const Epi& E, const int wv) {
    int tid; asm volatile("v_mbcnt_lo_u32_b32 %0, -1, 0\n\tv_mbcnt_hi_u32_b32 %0, -1, %0" : "=v"(tid)); tid += wv * 64; const int wid = __builtin_amdgcn_readfirstlane(tid >> 6), lane = tid & 63, wr = wid >> 2, wc = wid & 3, fr = lane & 15, fq = lane >> 4;
    const int K = g.K, nt = K / BK;
    unsigned voffA[2], voffB[2];
#pragma unroll
    for (int i = 0; i < 2; ++i) { int R, C; stage_rc(tid * 16 + i * 8192, R, C); const int Rb = Epi::PERM ? ((R & ~31) + perm32(R & 31)) : R;
        voffA[i] = (unsigned)(R * K + C) * 2u; voffB[i] = (unsigned)(Rb * K + C) * 2u; }
    const size_t kstep = (size_t)(BK * 2);
    const size_t hstep = (size_t)HALF * K * 2;
    const size_t tstep = 2 * hstep;
    const unsigned ldsw = (unsigned)wid * 1024u;
    const int aoff = lds_byte(wr * 64 + fr, fq * 8), boff = lds_byte(wc * 32 + fr, fq * 8);
#define PG8_SA(b, h) (((b) * 2 + (h)) * HTB)
#define PG8_SB(b, h) ((4 + (b) * 2 + (h)) * HTB)
#define PG8_STAGE(bufoff, gbase, voff) do { _Pragma("unroll") for (int _i = 0; _i < 2; ++_i) \
        __builtin_amdgcn_global_load_lds((const unsigned*)((const char*)(gbase) + (voff)[_i]), (PG8_LAS unsigned*)(lds + (bufoff) + ldsw + _i * 8192), 16, 0, 0); } while (0)
#define PG8_LDA(dst, b, h) do { _Pragma("unroll") for (int m = 0; m < 4; ++m) _Pragma("unroll") for (int k = 0; k < 2; ++k) dst[m][k] = *(const PG8_LAS bf16x8*)(lds + PG8_SA(b, h) + aoff + m * 2048 + k * 1024); } while (0)
#define PG8_LDB(dst, b, h) do { _Pragma("unroll") for (int n = 0; n < 2; ++n) _Pragma("unroll") for (int k = 0; k < 2; ++k) dst[n][k] = *(const PG8_LAS bf16x8*)(lds + PG8_SB(b, h) + boff + n * 2048 + k * 1024); } while (0)
#define PG8_MMA(ai, bj, At, Bt) do { __builtin_amdgcn_s_setprio(1); _Pragma("unroll") for (int m = 0; m < 4; ++m) _Pragma("unroll") for (int n = 0; n < 2; ++n) _Pragma("unroll") for (int k = 0; k < 2; ++k) \
        acc[ai][bj][m][n] = __builtin_amdgcn_mfma_f32_16x16x32_bf16(Bt[n][k], At[m][k], acc[ai][bj][m][n], 0, 0, 0); __builtin_amdgcn_s_setprio(0); } while (0)
#define PG8_WAIT_V(n) asm volatile("s_waitcnt vmcnt(" #n ")" ::: "memory")
#define PG8_WAIT_L(n) asm volatile("s_waitcnt lgkmcnt(" #n ")" ::: "memory")
#define PG8_BAR __builtin_amdgcn_s_barrier()
#define PG8_SCHED __builtin_amdgcn_sched_barrier(0)
    Unit cur, nxt; int ui = 0;
    if (!S.next(0, cur)) return;
    f32x4 acc[2][2][4][2]; float zf = 0.f; asm volatile("" : "+v"(zf));
#pragma unroll
    for (int a = 0; a < 2; ++a)
#pragma unroll
        for (int b = 0; b < 2; ++b)
#pragma unroll
            for (int m = 0; m < 4; ++m)
#pragma unroll
                for (int n = 0; n < 2; ++n) acc[a][b][m][n] = (f32x4){zf, zf, zf, zf};
    bf16x8 At[4][2], B0[2][2], B1[2][2];
    const char* cA = (const char*)g.A + (size_t)cur.pm * tstep; const char* cB = (const char*)g.Bt + (size_t)cur.pn * tstep;
    S.a_ready(cur);
    if constexpr (SP2) {
        PG8_STAGE(PG8_SB(0, 0), cB, voffB); PG8_STAGE(PG8_SB(0, 1), cB + hstep, voffB); PG8_STAGE(PG8_SA(0, 0), cA, voffA); PG8_STAGE(PG8_SA(0, 1), cA + hstep, voffA);
        if (wr == 1) PG8_BAR;
        PG8_WAIT_V(2); PG8_BAR;
        PG8_STAGE(PG8_SB(1, 0), cB + kstep, voffB); PG8_STAGE(PG8_SA(1, 0), cA + kstep, voffA); PG8_STAGE(PG8_SB(1, 1), cB + hstep + kstep, voffB);
        PG8_WAIT_V(6); PG8_BAR;
    } else {
        PG8_STAGE(PG8_SB(0, 0), cB, voffB); PG8_STAGE(PG8_SA(0, 0), cA, voffA); PG8_STAGE(PG8_SB(0, 1), cB + hstep, voffB); PG8_STAGE(PG8_SA(0, 1), cA + hstep, voffA);
        if (wr == 1) PG8_BAR;
        PG8_WAIT_V(4); PG8_BAR;
        PG8_STAGE(PG8_SB(1, 0), cB + kstep, voffB); PG8_STAGE(PG8_SA(1, 0), cA + kstep, voffA); PG8_STAGE(PG8_SB(1, 1), cB + hstep + kstep, voffB);
        PG8_WAIT_V(6); PG8_BAR;
    }
    for (;;) {
        const bool has_next = S.next(ui + 1, nxt);
        const char* nA = has_next ? (const char*)g.A + (size_t)nxt.pm * tstep : cA; const char* nB = has_next ? (const char*)g.Bt + (size_t)nxt.pn * tstep : cB;
        for (int t = 0; t < nt; t += 2) {
            const bool last = (t == nt - 2);
            const char* a1 = cA + (size_t)(t + 1) * kstep;
            const char* a2 = last ? nA : cA + (size_t)(t + 2) * kstep; const char* b2 = last ? nB : cB + (size_t)(t + 2) * kstep;
            const char* a3 = a2 + kstep; const char* b3 = b2 + kstep;
            if (last && has_next) S.a_ready(nxt);
            if constexpr (SP2) {
            PG8_LDB(B0, 0, 0); PG8_LDB(B1, 0, 1); PG8_SCHED; PG8_LDA(At, 0, 0); PG8_STAGE(PG8_SA(1, 1), a1 + hstep, voffA);
            PG8_WAIT_V(8); PG8_WAIT_L(0); PG8_BAR; PG8_MMA(0, 0, At, B0); PG8_MMA(0, 1, At, B1); PG8_BAR; PG8_SCHED;
            PG8_LDA(At, 0, 1); PG8_STAGE(PG8_SB(0, 0), b2, voffB); PG8_STAGE(PG8_SB(0, 1), b2 + hstep, voffB); PG8_STAGE(PG8_SA(0, 0), a2, voffA);
            PG8_WAIT_V(8); PG8_WAIT_L(0); PG8_BAR; PG8_MMA(1, 0, At, B0); PG8_MMA(1, 1, At, B1); PG8_BAR; PG8_SCHED;
            PG8_LDB(B0, 1, 0); PG8_LDB(B1, 1, 1); PG8_SCHED; PG8_LDA(At, 1, 0); PG8_STAGE(PG8_SA(0, 1), a2 + hstep, voffA);
            PG8_WAIT_V(8); PG8_WAIT_L(0); PG8_BAR; PG8_MMA(0, 0, At, B0); PG8_MMA(0, 1, At, B1); PG8_BAR; PG8_SCHED;
            PG8_LDA(At, 1, 1); PG8_STAGE(PG8_SB(1, 0), b3, voffB); PG8_STAGE(PG8_SB(1, 1), b3 + hstep, voffB); PG8_STAGE(PG8_SA(1, 0), a3, voffA);
            PG8_WAIT_V(8); PG8_WAIT_L(0); PG8_BAR; PG8_MMA(1, 0, At, B0); PG8_MMA(1, 1, At, B1); PG8_BAR; PG8_SCHED;
            } else {
            PG8_LDB(B0, 0, 0); PG8_SCHED; PG8_LDA(At, 0, 0); PG8_STAGE(PG8_SA(1, 1), a1 + hstep, voffA);
            PG8_WAIT_L(8); PG8_BAR; PG8_WAIT_L(0); PG8_MMA(0, 0, At, B0); PG8_BAR; PG8_SCHED;
            PG8_LDB(B1, 0, 1); PG8_STAGE(PG8_SB(0, 0), b2, voffB);
            PG8_BAR; PG8_WAIT_L(0); PG8_MMA(0, 1, At, B1); PG8_BAR;
            PG8_LDA(At, 0, 1); PG8_STAGE(PG8_SA(0, 0), a2, voffA);
            PG8_BAR; PG8_WAIT_L(0); PG8_MMA(1, 0, At, B0); PG8_BAR; PG8_SCHED;
            PG8_STAGE(PG8_SB(0, 1), b2 + hstep, voffB);
            PG8_WAIT_V(6); PG8_BAR; PG8_MMA(1, 1, At, B1); PG8_BAR;
            PG8_LDB(B0, 1, 0); PG8_SCHED; PG8_LDA(At, 1, 0); PG8_STAGE(PG8_SA(0, 1), a2 + hstep, voffA);
            PG8_WAIT_L(8); PG8_BAR; PG8_WAIT_L(0); PG8_MMA(0, 0, At, B0); PG8_BAR; PG8_SCHED;
            PG8_LDB(B1, 1, 1); PG8_STAGE(PG8_SB(1, 0), b3, voffB);
            PG8_BAR; PG8_WAIT_L(0); PG8_MMA(0, 1, At, B1); PG8_BAR;
            PG8_LDA(At, 1, 1); PG8_STAGE(PG8_SA(1, 0), a3, voffA);
            PG8_BAR; PG8_WAIT_L(0); PG8_MMA(1, 0, At, B0); PG8_BAR; PG8_SCHED;
            PG8_STAGE(PG8_SB(1, 1), b3 + hstep, voffB);
            PG8_WAIT_V(6); PG8_BAR; PG8_MMA(1, 1, At, B1); PG8_BAR;
            }
        }
        if constexpr (ALIGN_EPI) { if (wr == 0) PG8_BAR; }
        if constexpr (!Epi::AFTER_DRAIN) { E(acc, cur, wr, wc, fr, fq); S.done(cur); }
        if (!has_next) break;
        asm volatile("" : "+v"(zf));
#pragma unroll
        for (int a = 0; a < 2; ++a)
#pragma unroll
            for (int b = 0; b < 2; ++b)
#pragma unroll
                for (int m = 0; m < 4; ++m)
#pragma unroll
                    for (int n = 0; n < 2; ++n) acc[a][b][m][n] = (f32x4){zf, zf, zf, zf};
        cur = nxt; cA = nA; cB = nB; ++ui;
        if constexpr (ALIGN_EPI) { if (wr == 1) PG8_BAR; }
    }
    PG8_WAIT_V(0);
    if constexpr (!ALIGN_EPI) { if (wr == 0) PG8_BAR; }
    PG8_BAR;
    if constexpr (Epi::AFTER_DRAIN) { E.fused(acc, cur, wr, wc, fr, fq, lds, wid, lane); S.done(cur); }
#undef PG8_SA
#undef PG8_SB
#undef PG8_STAGE
#undef PG8_LDA
#undef PG8_LDB
#undef PG8_MMA
#undef PG8_WAIT_V
#undef PG8_WAIT_L
#undef PG8_BAR
#undef PG8_SCHED
}
}
namespace att {
using bf16 = __hip_bfloat16;
using bf16x8 = __attribute__((ext_vector_type(8))) short;
using s16x4  = __attribute__((ext_vector_type(4))) short;
using f32x16 = __attribute__((ext_vector_type(16))) float;
using u32x4  = __attribute__((ext_vector_type(4))) unsigned;
constexpr int NW = 8, QBLK = 32, KVBLK = 64, SEQ = 2048;
constexpr float THR2 = 11.5f;
#define KSWZ(row, colB) ((row) * 256 + ((colB) ^ (((row) & 7) << 4)))
#define SBAR() __builtin_amdgcn_sched_barrier(0)
__device__ __forceinline__ int crow(int r, int hi) { return (r & 3) + 8 * (r >> 2) + 4 * hi; }
__device__ __forceinline__ unsigned cvtpk(float lo, float hi) { unsigned r; asm volatile("v_cvt_pk_bf16_f32 %0, %1, %2" : "=v"(r) : "v"(lo), "v"(hi)); return r; }
__device__ __forceinline__ bf16x8 ld8(const bf16* p) { return *(const GAS bf16x8*)p; }
__device__ __forceinline__ void partialSM(f32x16& p0, f32x16& p1, float& m_reg, float& alpha) {
  float pmax = p0[0];
#pragma unroll
  for (int r = 1; r < 16; ++r) pmax = fmaxf(pmax, p0[r]);
#pragma unroll
  for (int r = 0; r < 16; ++r) pmax = fmaxf(pmax, p1[r]);
  { auto rr = __builtin_amdgcn_permlane32_swap(__float_as_uint(pmax), __float_as_uint(pmax), false, false);
    pmax = fmaxf(__uint_as_float(rr[0]), __uint_as_float(rr[1])); }
  float mn;
  if (__builtin_expect(__all(pmax - m_reg <= THR2), 1)) { mn = m_reg; alpha = 1.f; }
  else { mn = fmaxf(m_reg, pmax); alpha = __builtin_amdgcn_exp2f(m_reg - mn); m_reg = mn; }
#pragma unroll
  for (int r = 0; r < 16; ++r) { p0[r] -= mn; p1[r] -= mn; }
#pragma unroll
  for (int r = 0; r < 16; ++r) p0[r] = __builtin_amdgcn_exp2f(p0[r]);
}
__device__ __forceinline__ void partialSM_neg(f32x16& p0, f32x16& p1, float& m_reg, f32x16& negm, float& alpha, const bool first) {
  float pmax = p0[0];
#pragma unroll
  for (int r = 1; r < 16; ++r) pmax = fmaxf(pmax, p0[r]);
#pragma unroll
  for (int r = 0; r < 16; ++r) pmax = fmaxf(pmax, p1[r]);
  { auto rr = __builtin_amdgcn_permlane32_swap(__float_as_uint(pmax), __float_as_uint(pmax), false, false);
    pmax = fmaxf(__uint_as_float(rr[0]), __uint_as_float(rr[1])); }
  alpha = 1.f;
  if (first || !__all(pmax <= THR2)) { const float dl = first ? pmax : fmaxf(pmax, 0.f); m_reg += dl; if (!first) alpha = __builtin_amdgcn_exp2f(-dl);
#pragma unroll
    for (int r = 0; r < 16; ++r) { p0[r] -= dl; p1[r] -= dl; }
#pragma unroll
    for (int r = 0; r < 16; ++r) negm[r] = -m_reg;
    asm volatile("" : "+v"(negm)); }
#pragma unroll
  for (int r = 0; r < 16; ++r) p0[r] = __builtin_amdgcn_exp2f(p0[r]);
}
__device__ __forceinline__ void finishSM(f32x16& p0, f32x16& p1, bf16x8& pa0, bf16x8& pa1, bf16x8& pa2, bf16x8& pa3) {
#pragma unroll
  for (int r = 0; r < 16; ++r) p1[r] = __builtin_amdgcn_exp2f(p1[r]);
#define PK4(P, BASE, OUT) do { unsigned a0 = cvtpk(P[BASE + 0], P[BASE + 1]), a1 = cvtpk(P[BASE + 2], P[BASE + 3]);   \
    unsigned b0 = cvtpk(P[BASE + 4], P[BASE + 5]), b1 = cvtpk(P[BASE + 6], P[BASE + 7]);                              \
    auto r0 = __builtin_amdgcn_permlane32_swap(a0, b0, false, false); auto r1 = __builtin_amdgcn_permlane32_swap(a1, b1, false, false); \
    u32x4 w = {r0[0], r1[0], r0[1], r1[1]}; OUT = *reinterpret_cast<bf16x8*>(&w); } while (0)
  PK4(p0, 0, pa0); PK4(p0, 8, pa1); PK4(p1, 0, pa2); PK4(p1, 8, pa3);
#undef PK4
}
template <int NCB> __device__ __forceinline__ int v_st(int k, int c) { const int kk = (k & ~0xC) | ((k & 4) << 1) | ((k & 8) >> 1); return ((kk >> 3) * NCB + (c >> 5)) * 512 + ((kk & 7) * 32 + (c & 31)) * 2; }
__device__ __forceinline__ int v_rd_base(int lane) { return ((lane & 3) << 3) | (((lane >> 2) & 3) << 6) | (((lane >> 4) & 1) << 5) | (((lane >> 5) & 1) << 8); }
template <int OFF> __device__ __forceinline__ s16x4 tr_read(int vb) { s16x4 r; asm volatile("ds_read_b64_tr_b16 %0, %1 offset:%2" : "=&v"(r) : "v"(vb), "i"(OFF) : "memory"); return r; }
template <int NCB, int D0> __device__ __forceinline__ void pv_one(f32x16& od, int vb, bf16x8 pa0, bf16x8 pa1, bf16x8 pa2, bf16x8 pa3) {
#define VO(ks, half) (((2 * (ks) + (half)) * NCB + D0) * 512)
  const s16x4 l0 = tr_read<VO(0, 0)>(vb), h0 = tr_read<VO(0, 1)>(vb), l1 = tr_read<VO(1, 0)>(vb), h1 = tr_read<VO(1, 1)>(vb);
  const s16x4 l2 = tr_read<VO(2, 0)>(vb), h2 = tr_read<VO(2, 1)>(vb), l3 = tr_read<VO(3, 0)>(vb), h3 = tr_read<VO(3, 1)>(vb);
#undef VO
  asm volatile("s_waitcnt lgkmcnt(0)" ::: "memory"); SBAR();
#define PK(L, H) (bf16x8){L[0], L[1], L[2], L[3], H[0], H[1], H[2], H[3]}
  od = __builtin_amdgcn_mfma_f32_32x32x16_bf16(pa0, PK(l0, h0), od, 0, 0, 0);
  od = __builtin_amdgcn_mfma_f32_32x32x16_bf16(pa1, PK(l1, h1), od, 0, 0, 0);
  od = __builtin_amdgcn_mfma_f32_32x32x16_bf16(pa2, PK(l2, h2), od, 0, 0, 0);
  od = __builtin_amdgcn_mfma_f32_32x32x16_bf16(pa3, PK(l3, h3), od, 0, 0, 0);
#undef PK
}

__device__ __forceinline__ void lsum_mma(f32x16& lacc, bf16x8 pa0, bf16x8 pa1, bf16x8 pa2, bf16x8 pa3) {
  const short one = (short)0x3F80; const bf16x8 ones = {one, one, one, one, one, one, one, one};
  lacc = __builtin_amdgcn_mfma_f32_32x32x16_bf16(pa0, ones, lacc, 0, 0, 0); lacc = __builtin_amdgcn_mfma_f32_32x32x16_bf16(pa1, ones, lacc, 0, 0, 0);
  lacc = __builtin_amdgcn_mfma_f32_32x32x16_bf16(pa2, ones, lacc, 0, 0, 0); lacc = __builtin_amdgcn_mfma_f32_32x32x16_bf16(pa3, ones, lacc, 0, 0, 0);
}
constexpr int MLA_KROW = 208;
constexpr int MLA_SHV = 64 * 64 * 2, MLA_SHK = 64 * MLA_KROW;
__device__ __forceinline__ void mla_kload(bf16x8* kf, const char* Ks, int r32, int hi) {
#pragma unroll
  for (int d0 = 0; d0 < 6; ++d0) { const int cb = (d0 * 16 + hi * 8) * 2;
    kf[2 * d0] = *reinterpret_cast<const bf16x8*>(Ks + r32 * MLA_KROW + cb); kf[2 * d0 + 1] = *reinterpret_cast<const bf16x8*>(Ks + (32 + r32) * MLA_KROW + cb); }
}
__device__ __forceinline__ void mla_qkt(f32x16& p0, f32x16& p1, const bf16x8* kf, const bf16x8* qr, const f32x16& negm) {
  p0 = __builtin_amdgcn_mfma_f32_32x32x16_bf16(kf[0], qr[0], negm, 0, 0, 0);
  p1 = __builtin_amdgcn_mfma_f32_32x32x16_bf16(kf[1], qr[0], negm, 0, 0, 0);
#pragma unroll
  for (int d0 = 1; d0 < 6; ++d0) {
    p0 = __builtin_amdgcn_mfma_f32_32x32x16_bf16(kf[2 * d0], qr[d0], p0, 0, 0, 0);
    p1 = __builtin_amdgcn_mfma_f32_32x32x16_bf16(kf[2 * d0 + 1], qr[d0], p1, 0, 0, 0); }
}
__device__ __forceinline__ void mla_pv(f32x16* o, int vb, bf16x8 pa0, bf16x8 pa1, bf16x8 pa2, bf16x8 pa3) {
  pv_one<2, 0>(o[0], vb, pa0, pa1, pa2, pa3); pv_one<2, 1>(o[1], vb, pa0, pa1, pa2, pa3); lsum_mma(o[2], pa0, pa1, pa2, pa3);
}
__device__ __forceinline__ void mla_unit(const bf16* __restrict__ Qb, const bf16* __restrict__ Kn, const bf16* __restrict__ Kr, bf16* __restrict__ Ob, char* lds, const int wv) {
  int tid; asm volatile("v_mbcnt_lo_u32_b32 %0, -1, 0\n\tv_mbcnt_hi_u32_b32 %0, -1, %0" : "=v"(tid)); tid += wv * 64; const int wid = __builtin_amdgcn_readfirstlane(tid >> 6), lane = tid & 63, r32 = lane & 31, hi = lane >> 5;
  const bf16* Vh = Kn + 64;
  char* V_lds = lds; char* K_lds = lds + 4 * MLA_SHV;
  float* ws = (float*)(lds + 4 * MLA_SHV + 4 * MLA_SHK) + wid * 64; float* al_l = ws + 32;
  float m_reg = 0.f; f32x16 o[3] = {}; bf16x8 qr[6]; f32x16 negm = {}; asm volatile("" : "+v"(negm));
  const bf16* Qw = Qb + (long)(wid * QBLK + r32) * 768 + hi * 8;
#pragma unroll
  for (int d0 = 0; d0 < 6; ++d0) qr[d0] = ld8(Qw + d0 * 16);
  const int sr = tid >> 3, sc = (tid & 7) * 8, rr = (tid >> 2) & 63, rc = (tid & 3) * 8;
  const int vst = v_st<2>(sr, sc), kst = sr * MLA_KROW + sc * 2, krst = rr * MLA_KROW + 128 + rc * 2;
  const int vb0 = (int)(uintptr_t)V_lds + v_rd_base(lane);
  struct { bf16x8 vs, kn, kr; } sg[2];
#define SLOAD(s, k0) do { sg[s].vs = ld8(&Vh[(long)((k0) + sr) * 1024 + sc]); sg[s].kn = ld8(&Kn[(long)((k0) + sr) * 1024 + sc]); sg[s].kr = ld8(&Kr[(long)((k0) + rr) * 32 + rc]); } while (0)
#define SWRITE(b, s) do { *(bf16x8*)(V_lds + (b) * MLA_SHV + vst) = sg[s].vs; *(bf16x8*)(K_lds + (b) * MLA_SHK + kst) = sg[s].kn; *(bf16x8*)(K_lds + (b) * MLA_SHK + krst) = sg[s].kr; } while (0)
#define RESC(a) do { if (__any((a) < 1.f)) { if (hi == 0) al_l[r32] = (a); asm volatile("s_waitcnt lgkmcnt(0)" ::: "memory"); \
    _Pragma("unroll") for (int d = 0; d < 3; ++d) _Pragma("unroll") for (int r = 0; r < 16; ++r) o[d][r] *= al_l[crow(r, hi)]; } } while (0)
  f32x16 p0, p1; float al; bf16x8 pa0, pa1, pa2, pa3; const int NT = SEQ / KVBLK;
  SLOAD(0, 0); SLOAD(1, KVBLK); asm volatile("s_waitcnt vmcnt(0)" ::: "memory"); SWRITE(0, 0); SWRITE(1, 1); SLOAD(0, 2 * KVBLK); __syncthreads();
  { bf16x8 kf[12]; mla_kload(kf, K_lds, r32, hi); mla_qkt(p0, p1, kf, qr, negm); }
  if (wid >= 4) __syncthreads();
  for (int i = 0; i < NT; ++i) {
    __syncthreads();
    partialSM_neg(p0, p1, m_reg, negm, al, i == 0); finishSM(p0, p1, pa0, pa1, pa2, pa3);
    if (i + 2 < NT) { SWRITE((i + 2) & 3, 0); if (i + 3 < NT) SLOAD(0, (i + 3) * KVBLK); }
    RESC(al);
    __syncthreads();
    __builtin_amdgcn_s_setprio(1); SBAR();
    if (i + 1 < NT) { bf16x8 kf[12]; mla_kload(kf, K_lds + ((i + 1) & 3) * MLA_SHK, r32, hi); SBAR(); mla_qkt(p0, p1, kf, qr, negm); }
    mla_pv(o, vb0 + (i & 3) * MLA_SHV, pa0, pa1, pa2, pa3); __builtin_amdgcn_s_setprio(0);
  }
  if (wid < 4) __syncthreads();
  float rli[16];
#pragma unroll
  for (int r = 0; r < 16; ++r) rli[r] = __builtin_amdgcn_rcpf(o[2][r]);
  __syncthreads();
  { bf16* stg = (bf16*)(lds + wid * 4096);
#pragma unroll
    for (int r = 0; r < 16; ++r) { const int orow = crow(r, hi);
#pragma unroll
      for (int d0 = 0; d0 < 2; ++d0) stg[orow * 64 + d0 * 32 + r32] = __float2bfloat16(o[d0][r] * rli[r]); }
    asm volatile("s_waitcnt lgkmcnt(0)" ::: "memory");
    bf16* Ow = Ob + (long)(wid * QBLK) * 1024;
#pragma unroll
    for (int i = 0; i < 4; ++i) { const int row = i * 8 + (lane >> 3), ch = lane & 7; const u32x4 v = *(const u32x4*)(stg + row * 64 + ch * 8); *(GAS u32x4*)(Ow + (long)row * 1024 + ch * 8) = v; } }
  __syncthreads();
#undef SLOAD
#undef SWRITE
#undef RESC
}

constexpr int DF_SH = 64 * 128 * 2;
__device__ __forceinline__ void df_kload(bf16x8* kf, const char* Ks, int r32, int hi, int mapc) {
#pragma unroll
  for (int d0 = 0; d0 < 4; ++d0) { const int cb = mapc + (d0 * 16 + hi * 8) * 2;
    kf[2 * d0] = *reinterpret_cast<const bf16x8*>(Ks + KSWZ(r32, cb)); kf[2 * d0 + 1] = *reinterpret_cast<const bf16x8*>(Ks + KSWZ(32 + r32, cb)); }
}
__device__ __forceinline__ void df_qkt(f32x16& p0, f32x16& p1, const bf16x8* kf, const bf16x8* qr) {
  p0 = f32x16{}; p1 = f32x16{};
#pragma unroll
  for (int d0 = 0; d0 < 4; ++d0) {
    p0 = __builtin_amdgcn_mfma_f32_32x32x16_bf16(kf[2 * d0], qr[d0], p0, 0, 0, 0);
    p1 = __builtin_amdgcn_mfma_f32_32x32x16_bf16(kf[2 * d0 + 1], qr[d0], p1, 0, 0, 0); }
}
__device__ __forceinline__ void df_bias(f32x16& p0, f32x16& p1, float dbase, float nslope2) {
#pragma unroll
  for (int r = 0; r < 16; ++r) { const float c = (float)((r & 3) + 8 * (r >> 2));
    p0[r] = fmaf(fabsf(dbase + c), nslope2, p0[r]); p1[r] = fmaf(fabsf(dbase + (c + 32.f)), nslope2, p1[r]); }
}
__device__ __forceinline__ void df_pv(f32x16* o, int vb, bf16x8 pa0, bf16x8 pa1, bf16x8 pa2, bf16x8 pa3) {
  pv_one<4, 0>(o[0], vb, pa0, pa1, pa2, pa3); pv_one<4, 1>(o[1], vb, pa0, pa1, pa2, pa3); pv_one<4, 2>(o[2], vb, pa0, pa1, pa2, pa3); pv_one<4, 3>(o[3], vb, pa0, pa1, pa2, pa3); lsum_mma(o[4], pa0, pa1, pa2, pa3);
}
__device__ __forceinline__ void diff_unit(const bf16* __restrict__ Qb, const bf16* __restrict__ Kh, const bf16* __restrict__ Vh, bf16* __restrict__ Ob, int qpos0,
                                          float nslope2, float lam, const float* __restrict__ gsub, float outscale, char* lds, const int wv) {
  int tid; asm volatile("v_mbcnt_lo_u32_b32 %0, -1, 0\n\tv_mbcnt_hi_u32_b32 %0, -1, %0" : "=v"(tid)); tid += wv * 64; const int wid = __builtin_amdgcn_readfirstlane(tid >> 6), lane = tid & 63, r32 = lane & 31, hi = lane >> 5;
  const int map = wid >> 2, wq = wid & 3, mapc = map * 128;
  char* V_lds = lds; char* K_lds = lds + 4 * DF_SH;
  float* ws = (float*)(lds + 8 * DF_SH) + wid * 64; float* al_l = ws + 32;
  float m_reg = -1e30f; f32x16 o[5] = {}; bf16x8 qr[4];
  const bf16* Qw = Qb + (long)(wq * QBLK + r32) * 512 + map * 64 + hi * 8;
#pragma unroll
  for (int d0 = 0; d0 < 4; ++d0) qr[d0] = ld8(Qw + d0 * 16);
  const float dq0 = (float)(4 * hi - (qpos0 + wq * QBLK + r32));
  const int sr = tid >> 4, sc = (tid & 15) * 8, vst0 = v_st<4>(sr, sc), vst1 = v_st<4>(32 + sr, sc);
  const int vb0 = (int)(uintptr_t)V_lds + v_rd_base(lane);
  struct { bf16x8 vs0, vs1, ks0, ks1; } sg[2];
#define SLOAD(s, k0) do { sg[s].vs0 = ld8(&Vh[(long)((k0) + sr) * 512 + sc]); sg[s].vs1 = ld8(&Vh[(long)((k0) + 32 + sr) * 512 + sc]); \
    sg[s].ks0 = ld8(&Kh[(long)((k0) + sr) * 512 + sc]); sg[s].ks1 = ld8(&Kh[(long)((k0) + 32 + sr) * 512 + sc]); } while (0)
#define SWRITE(b, s) do { *(bf16x8*)(V_lds + (b) * DF_SH + vst0) = sg[s].vs0; *(bf16x8*)(V_lds + (b) * DF_SH + vst1) = sg[s].vs1; const int kc = sc * 2; \
    *(bf16x8*)(K_lds + (b) * DF_SH + KSWZ(sr, kc)) = sg[s].ks0; *(bf16x8*)(K_lds + (b) * DF_SH + KSWZ(32 + sr, kc)) = sg[s].ks1; } while (0)
#define RESC(a) do { if (__any((a) < 1.f)) { if (hi == 0) al_l[r32] = (a); asm volatile("s_waitcnt lgkmcnt(0)" ::: "memory"); \
    _Pragma("unroll") for (int d = 0; d < 5; ++d) _Pragma("unroll") for (int r = 0; r < 16; ++r) o[d][r] *= al_l[crow(r, hi)]; } } while (0)
  f32x16 p0, p1; float al; bf16x8 pa0, pa1, pa2, pa3; const int NT = SEQ / KVBLK;
  SLOAD(0, 0); SLOAD(1, KVBLK); asm volatile("s_waitcnt vmcnt(0)" ::: "memory"); SWRITE(0, 0); SWRITE(1, 1); SLOAD(0, 2 * KVBLK); __syncthreads();
  { bf16x8 kf[8]; df_kload(kf, K_lds, r32, hi, mapc); df_qkt(p0, p1, kf, qr); }
  if (wid >= 4) __syncthreads();
  for (int i = 0; i < NT; ++i) {
    __syncthreads();
    df_bias(p0, p1, dq0 + (float)(i * KVBLK), nslope2); partialSM(p0, p1, m_reg, al); finishSM(p0, p1, pa0, pa1, pa2, pa3);
    if (i + 2 < NT) { SWRITE((i + 2) & 3, 0); if (i + 3 < NT) SLOAD(0, (i + 3) * KVBLK); }
    RESC(al);
    __syncthreads();
    __builtin_amdgcn_s_setprio(1); SBAR();
    if (i + 1 < NT) { bf16x8 kf[8]; df_kload(kf, K_lds + ((i + 1) & 3) * DF_SH, r32, hi, mapc); SBAR(); df_qkt(p0, p1, kf, qr); }
    df_pv(o, vb0 + (i & 3) * DF_SH, pa0, pa1, pa2, pa3); __builtin_amdgcn_s_setprio(0);
  }
  if (wid < 4) __syncthreads();
  float rli[16]; const float msc = map ? -lam : 1.f;
#pragma unroll
  for (int r = 0; r < 16; ++r) rli[r] = __builtin_amdgcn_rcpf(o[4][r]) * msc;
  __syncthreads();
  float* X = (float*)lds + wq * 4096;
  if (map == 1) {
#pragma unroll
    for (int d0 = 0; d0 < 4; ++d0)
#pragma unroll
      for (int r = 0; r < 16; ++r) X[(d0 * 16 + r) * 64 + lane] = o[d0][r] * rli[r];
  }
  __syncthreads();
  if (map == 0) {
#pragma unroll
    for (int d0 = 0; d0 < 4; ++d0)
#pragma unroll
      for (int r = 0; r < 16; ++r) o[d0][r] = o[d0][r] * rli[r] + X[(d0 * 16 + r) * 64 + lane];
    float g4[4];
#pragma unroll
    for (int d0 = 0; d0 < 4; ++d0) g4[d0] = ((const GAS float*)gsub)[d0 * 32 + r32] * outscale;
#pragma unroll
    for (int r = 0; r < 16; ++r) { float ss = (o[0][r] * o[0][r] + o[1][r] * o[1][r]) + (o[2][r] * o[2][r] + o[3][r] * o[3][r]);
      ss = xadd<1>(ss); ss = xadd<2>(ss); ss = xadd<4>(ss); ss = xadd<8>(ss); ss = xadd<16>(ss);
      rli[r] = rsqrtf(ss * (1.f / 128.f) + 1e-5f); }
    asm volatile("s_waitcnt lgkmcnt(0)" ::: "memory");
    bf16* stg = (bf16*)(lds + wq * 16384);
#pragma unroll
    for (int r = 0; r < 16; ++r) { const int orow = crow(r, hi);
#pragma unroll
      for (int d0 = 0; d0 < 4; ++d0) stg[orow * 128 + d0 * 32 + r32] = __float2bfloat16(o[d0][r] * rli[r] * g4[d0]); }
    asm volatile("s_waitcnt lgkmcnt(0)" ::: "memory");
    bf16* Ow = Ob + (long)(wq * QBLK) * 1024;
#pragma unroll
    for (int i = 0; i < 8; ++i) { const int row = i * 4 + (lane >> 4), ch = lane & 15; const u32x4 v = *(const u32x4*)(stg + row * 128 + ch * 8); *(GAS u32x4*)(Ow + (long)row * 1024 + ch * 8) = v; }
  }
  __syncthreads();
#undef SLOAD
#undef SWRITE
#undef RESC
}
#undef SBAR
}
constexpr int NWAVES = 8;
constexpr int SEQ = 2048, NBATCH = 32, M = NBATCH * SEQ, DM = 1024, PIN = 2080, PINP = 2304, FF = 4096, NLAYER = 2;
constexpr size_t MiB = 1u << 20;
constexpr size_t WS_SSQ = 0, WS_CS = 4 * MiB, WS_WIN = 5 * MiB, WS_WUQ = 14 * MiB, WS_WUKV = 15 * MiB, WS_WOUT = 16 * MiB, WS_WUP = 20 * MiB, WS_WDN = 36 * MiB;
constexpr size_t WS_HB = 52 * MiB, WS_CQ = 180 * MiB, WS_CKV = 212 * MiB, WS_DQ = 244 * MiB, WS_DK = 308 * MiB, WS_DV = 372 * MiB, WS_KR = 436 * MiB, WS_Q = 440 * MiB, WS_KV = 536 * MiB, WS_O = 664 * MiB;
static_assert(WS_CQ == pg8::ZO_CQ && WS_CKV == WS_CQ + pg8::ZS_CQ && WS_DQ == pg8::ZO_DQ && WS_DK == WS_DQ + pg8::ZS_DQ && WS_DV == WS_DK + pg8::ZS_DQ && WS_KR == pg8::ZO_KR, "EpiZ offsets");
constexpr size_t WS_HID = 180 * MiB, WS_SSQP = 792 * MiB, WS_END = 828 * MiB;
constexpr int LDS_BYTES = 147456, PARAMS_OFF = 135168, XB_LDS_OFF = 135168 + 512;
constexpr size_t WS_BAR = 0, BAR_BYTES = 32768;
#define LAS __attribute__((address_space(3)))
typedef unsigned short bf16;
typedef unsigned v4u __attribute__((ext_vector_type(4)));
typedef unsigned v2u __attribute__((ext_vector_type(2)));
typedef float f32x4 __attribute__((ext_vector_type(4)));
#define RLX_AGENT __ATOMIC_RELAXED, __HIP_MEMORY_SCOPE_AGENT
#define XB_TMO      128
#define XB_XCNT(j)  (256  + 64 * (j))
#define XB_XSUB(j)  (1280 + 64 * (j))
#define XB_XGEN(j)  (2304 + 64 * (j))
#define XB_TOP      3328
#define XB_TOPGEN   3392
#define XCD_BAR_WORDS 3456
#define XB_SPIN_CAP (1u << 18)

__device__ __forceinline__ unsigned xb_ld(unsigned* p)              { return __hip_atomic_load(p, __ATOMIC_RELAXED, __HIP_MEMORY_SCOPE_AGENT); }
__device__ __forceinline__ unsigned xb_add(unsigned* p, unsigned v) { return __hip_atomic_fetch_add(p, v, __ATOMIC_RELAXED, __HIP_MEMORY_SCOPE_AGENT); }
__device__ __forceinline__ unsigned xb_xcc_id() { return (unsigned)__builtin_amdgcn_s_getreg((3 << 11) | 20) & 0xFu; }
#define XB_SPIN(cond, bar) do { unsigned _sp = 0; while (cond) { __builtin_amdgcn_s_sleep(1); \
    if ((++_sp & 255u) == 0u) { if (xb_ld(&(bar)[XB_TMO])) break; if (_sp > XB_SPIN_CAP) { atomicAdd(&(bar)[XB_TMO], 1u); break; } } } } while (0)

struct XcdBarrier {
    unsigned* bar; unsigned x;
    volatile LAS unsigned* st;
};

__device__ __forceinline__ XcdBarrier xcd_barrier_post(unsigned* bar, volatile LAS unsigned* st) {
    XcdBarrier b; b.bar = bar; b.x = xb_xcc_id(); b.st = st;
    if (threadIdx.x == 0) st[2] = xb_add(&bar[XB_XCNT(b.x)], 1u);
    return b;
}
__device__ __forceinline__ void xcd_barrier_complete(unsigned* bar, unsigned x, unsigned& nloc, unsigned& nx) {
    const unsigned G = gridDim.x * gridDim.y * gridDim.z;
    unsigned sum, cnt, mine, sp = 0u;
    for (;;) {
        sum = 0u; cnt = 0u; mine = 0u;
#pragma unroll
        for (unsigned j = 0; j < 16; ++j) { const unsigned c = xb_ld(&bar[XB_XCNT(j)]); sum += c; cnt += (c > 0u) ? 1u : 0u; mine = (j == x) ? c : mine; }
        if (sum == G) break;
        __builtin_amdgcn_s_sleep(1);
        if ((++sp & 255u) == 0u) { if (xb_ld(&bar[XB_TMO])) break; if (sp > XB_SPIN_CAP) { atomicAdd(&bar[XB_TMO], 1u); break; } }
    }
    nloc = mine > 0u ? mine : 1u; nx = cnt > 0u ? cnt : 1u;
}

__device__ __forceinline__ void xcd_barrier(const XcdBarrier& b) {
    asm volatile("s_waitcnt vmcnt(0)" ::: "memory");
    __syncthreads();
    if (threadIdx.x == 0) {
        unsigned* bar = b.bar;
        __builtin_amdgcn_s_waitcnt(0);
        unsigned nloc = b.st[0], nx = b.st[1];
        if (nloc == 0u) { xcd_barrier_complete(bar, b.x, nloc, nx); b.st[0] = nloc; b.st[1] = nx; }
        const unsigned old = xb_add(&bar[XB_XSUB(b.x)], 1u);
        const unsigned gen = old / nloc;
        if (old + 1u == (gen + 1u) * nloc) {
            __builtin_amdgcn_fence(__ATOMIC_RELEASE, "agent");
            asm volatile("s_waitcnt vmcnt(0)" ::: "memory");
            const unsigned og = xb_add(&bar[XB_TOP], 1u);
            const unsigned tg = og / nx;
            if (og + 1u == (tg + 1u) * nx) xb_add(&bar[XB_TOPGEN], 1u);
            else XB_SPIN(xb_ld(&bar[XB_TOPGEN]) == tg, bar);
            __builtin_amdgcn_fence(__ATOMIC_ACQUIRE, "agent");
            xb_add(&bar[XB_XGEN(b.x)], 1u);
            asm volatile("s_waitcnt vmcnt(0)" ::: "memory");
        } else {
            XB_SPIN(xb_ld(&bar[XB_XGEN(b.x)]) == gen, bar);
            __builtin_amdgcn_fence(__ATOMIC_ACQUIRE, "agent");
            asm volatile("s_waitcnt vmcnt(0)" ::: "memory");
        }
    }
    __syncthreads();
}

#define XL_SUB(j) (4096 + 64 * (j))
#define XL_GEN(j) (5120 + 64 * (j))
__device__ __forceinline__ void xcd_local_barrier(const XcdBarrier& b, unsigned target, unsigned k) {
    asm volatile("s_waitcnt vmcnt(0)" ::: "memory");
    __syncthreads();
    if (threadIdx.x == 0) {
        unsigned* bar = b.bar;
        const unsigned old = xb_add(&bar[XL_SUB(b.x)], 1u);
        if (old + 1u == target) (void)xb_add(&bar[XL_GEN(b.x)], 1u);
        else XB_SPIN(xb_ld(&bar[XL_GEN(b.x)]) < k, bar);
        __builtin_amdgcn_fence(__ATOMIC_ACQUIRE, "agent");
        asm volatile("s_waitcnt vmcnt(0)" ::: "memory");
    }
    __syncthreads();
}
__device__ __forceinline__ unsigned xcd_census_uniform(unsigned* bar, unsigned G) {
    unsigned pop = 0u, bad = 0u;
#pragma unroll
    for (unsigned j = 0; j < 16; ++j) { const unsigned c = xb_ld(&bar[XB_XCNT(j)]); pop += (c != 0u) ? 1u : 0u; bad |= (c != 0u && c * 8u != G) ? 1u : 0u; }
    return (pop == 8u && bad == 0u) ? 1u : 0u;
}
__device__ __forceinline__ unsigned pk2(float lo, float hi) { return pg8::cvt_pk_bf16(lo, hi); }
__device__ __forceinline__ float wave_sum(float v) {
    v = xadd<1>(v); v = xadd<2>(v); v = xadd<4>(v); v = xadd<8>(v); v = xadd<16>(v); v = xadd<32>(v);
    return v;
}
__device__ __forceinline__ void tr_item(const float* __restrict__ W, int N, int src_n0, int k0, int K, bf16* __restrict__ WTrow0, const float* __restrict__ gain, bool zero, bool perm, LAS float* scr, int lane) {
    const int s_ = lane & 31, col = perm ? (8 * ((s_ >> 2) & 3) + 4 * (s_ >> 4) + (s_ & 3)) : s_;
#pragma unroll
    for (int i = 0; i < 32; ++i) { const int kk = 2 * i + (lane >> 5); float v = 0.f;
        if (!zero) { v = ((const GAS float*)W)[(size_t)(k0 + kk) * N + src_n0 + (lane & 31)]; if (gain) v *= ((const GAS float*)gain)[k0 + kk]; }
        scr[kk * 33 + col] = v; }
    asm volatile("s_waitcnt lgkmcnt(0)" ::: "memory");
    const int c = lane & 7;
#pragma unroll
    for (int j = 0; j < 4; ++j) { const int n = (lane >> 3) + 8 * j; const LAS float* s = scr + (8 * c) * 33 + n;
        v4u o; o.x = pk2(s[0 * 33], s[1 * 33]); o.y = pk2(s[2 * 33], s[3 * 33]); o.z = pk2(s[4 * 33], s[5 * 33]); o.w = pk2(s[6 * 33], s[7 * 33]);
        *(GAS v4u*)(WTrow0 + (size_t)n * K + k0 + 8 * c) = o; }
    asm volatile("s_waitcnt lgkmcnt(0)" ::: "memory");
}
__device__ __forceinline__ const void* ldptr(const LAS void* q) { const LAS unsigned* w = (const LAS unsigned*)q; const unsigned lo = __builtin_amdgcn_readfirstlane(w[0]), hi = __builtin_amdgcn_readfirstlane(w[1]); return (const void*)(((unsigned long long)hi << 32) | lo); }
struct Params { const float* in[17]; float* out; unsigned char* ws; int ph_lo, ph_hi; float lam_init0, lam_init1; };
enum { I_X = 0, I_WIN, I_GMIX, I_GQ, I_GKV, I_WUQ, I_WUKV, I_LQ1, I_LK1, I_LQ2, I_LK2, I_GSUB, I_WOUT, I_GMLP, I_WUP, I_WDN, I_GFIN };
constexpr int N_PHASES = 14;
#ifndef REP_Z
#define REP_Z 1
#endif
#ifndef REP_UP
#define REP_UP 1
#endif
#ifndef REP_MLA
#define REP_MLA 1
#endif
#ifndef REP_DIFF
#define REP_DIFF 1
#endif
#ifndef PHM
#define PHM 127
#endif

__global__ void __launch_bounds__(NWAVES * 64, 2) fwd_mega(Params p) {
    extern __shared__ __attribute__((aligned(16))) unsigned char lds[];
    cg::grid_group grid = cg::this_grid();
    LAS unsigned char* ldsl = (LAS unsigned char*)lds;
    const int wv = __builtin_amdgcn_readfirstlane(threadIdx.x >> 6);
    const int G0 = gridDim.x, bx0 = blockIdx.x;
    if (threadIdx.x == 0) { LAS unsigned long long* w = (LAS unsigned long long*)(ldsl + PARAMS_OFF);
#pragma unroll
        for (int i = 0; i < 17; ++i) w[i] = (unsigned long long)(uintptr_t)p.in[i];
        w[17] = (unsigned long long)(uintptr_t)p.out; w[18] = (unsigned long long)(uintptr_t)p.ws;
        LAS float* wf = (LAS float*)(ldsl + PARAMS_OFF); wf[40] = p.lam_init0; wf[41] = p.lam_init1; }
    static_assert(offsetof(Params, out) == 136 && offsetof(Params, ws) == 144 && offsetof(Params, lam_init0) == 160 && offsetof(Params, lam_init1) == 164, "Params layout");
    __syncthreads();
    if (threadIdx.x < 4) ((LAS unsigned*)(ldsl + XB_LDS_OFF))[threadIdx.x] = 0u;
    __syncthreads();
    const XcdBarrier xbar = xcd_barrier_post((unsigned*)(p.ws + WS_BAR), (volatile LAS unsigned*)(ldsl + XB_LDS_OFF));
    const int ph_lo = __builtin_amdgcn_readfirstlane(p.ph_lo), ph_hi = __builtin_amdgcn_readfirstlane(p.ph_hi);
#define PIN_(k) ((const float*)ldptr(&PL->in[k]))

    unsigned n_local = 0u, k_local = 0u;
    for (int ph = ph_lo; ph < ph_hi; ++ph) {
        if (ph > ph_lo) {
            volatile LAS unsigned* xst = (volatile LAS unsigned*)(ldsl + XB_LDS_OFF);
            if (ph == ph_lo + 1) { grid.sync();
                if (threadIdx.x == 0) xst[3] = xcd_census_uniform(xbar.bar, (unsigned)G0);
                __syncthreads(); }
            else if (ph == N_PHASES - 1 || (ph - 1) % 6 == 4 || (ph - 1) % 6 == 0 || __builtin_amdgcn_readfirstlane(xst[3]) == 0u) xcd_barrier(xbar);
            else { n_local += (unsigned)G0 >> 3; ++k_local; xcd_local_barrier(xbar, n_local, k_local); }
        }
        int po = PARAMS_OFF, G = G0, bx = bx0;
        if (ph > ph_lo) { volatile LAS unsigned* xst = (volatile LAS unsigned*)(ldsl + XB_LDS_OFF);
            if (__builtin_amdgcn_readfirstlane(xst[3]) != 0u) bx = (int)(__builtin_amdgcn_readfirstlane(xst[2]) * 8u + xbar.x); }
        asm volatile("" : "+s"(po), "+s"(G), "+s"(bx));
        const int vcu = (G % 8 == 0) ? (bx % 8) * (G / 8) + bx / 8 : bx;
        const LAS Params* PL = (const LAS Params*)(ldsl + po);
        unsigned char* ws = (unsigned char*)ldptr(&PL->ws); float* out = (float*)ldptr(&PL->out);
        float* ssq = (float*)(ws + WS_SSQP); float* cs = (float*)(ws + WS_CS);
        bf16* HB = (bf16*)(ws + WS_HB); bf16* CQ = (bf16*)(ws + WS_CQ); bf16* CKV = (bf16*)(ws + WS_CKV); bf16* DQ = (bf16*)(ws + WS_DQ); bf16* DK = (bf16*)(ws + WS_DK); bf16* DV = (bf16*)(ws + WS_DV);
        bf16* KR = (bf16*)(ws + WS_KR); bf16* Qm = (bf16*)(ws + WS_Q); bf16* KV = (bf16*)(ws + WS_KV); bf16* Ob = (bf16*)(ws + WS_O); bf16* HID = (bf16*)(ws + WS_HID);

        if (ph == 0 && (PHM & 1)) {
            int tid; asm volatile("v_mbcnt_lo_u32_b32 %0, -1, 0\n\tv_mbcnt_hi_u32_b32 %0, -1, %0" : "=v"(tid)); tid += wv * 64; const int lane = tid & 63, wave = __builtin_amdgcn_readfirstlane(tid >> 6);
            const int gw = vcu * NWAVES + wave, NGW = G * NWAVES, gt = bx * (NWAVES * 64) + tid, GT = G * NWAVES * 64;
            for (int i = gt; i < SEQ * 16; i += GT) { const int pos = i >> 4, f = i & 15; const float inv = exp2f(-(float)f * (13.287712379549449f / 16.f));
                const float ang = (float)pos * inv; double rev = (double)ang * 0.15915494309189535; rev -= floor(rev); const float fr = (float)rev;
                ((GAS float*)cs)[pos * 32 + f] = __builtin_amdgcn_cosf(fr); ((GAS float*)cs)[pos * 32 + 16 + f] = __builtin_amdgcn_sinf(fr); }
            LAS float* scr = (LAS float*)(ldsl + wave * 16384);
            constexpr int I_IN = 16 * 72, I_UQ = 4 * 24, I_UKV = 4 * 32, I_OUT = 16 * 32, I_UP = 16 * 128, I_DN = 64 * 32, I_L = I_IN + I_UQ + I_UKV + I_OUT + I_UP + I_DN;
            for (int it = gw; it < NLAYER * I_L; it += NGW) {
                const int l = it / I_L; int r = it % I_L;
                if (r < I_IN) { const int kb = r / 72, nb = r % 72, n0 = 32 * nb; const bool zero = n0 > 2048; const int src = n0 < 512 ? n0 : (n0 < 2048 ? n0 + 32 : 512);
                    tr_item(PIN_(I_WIN) + (size_t)l * DM * PIN, PIN, src, 64 * kb, DM, (bf16*)(ws + WS_WIN) + ((size_t)l * PINP + n0) * DM, PIN_(I_GMIX) + l * DM, zero, n0 == 2048, scr, lane); continue; } r -= I_IN;
                if (r < I_UQ) { const int kb = r / 24, nb = r % 24;
                    tr_item(PIN_(I_WUQ) + (size_t)l * 256 * 768, 768, 32 * nb, 64 * kb, 256, (bf16*)(ws + WS_WUQ) + ((size_t)l * 768 + 32 * nb) * 256, PIN_(I_GQ) + l * 256, false, (nb % 3) == 2, scr, lane); continue; } r -= I_UQ;
                if (r < I_UKV) { const int kb = r / 32, nb = r % 32;
                    tr_item(PIN_(I_WUKV) + (size_t)l * 256 * 1024, 1024, 32 * nb, 64 * kb, 256, (bf16*)(ws + WS_WUKV) + ((size_t)l * 1024 + 32 * nb) * 256, PIN_(I_GKV) + l * 256, false, false, scr, lane); continue; } r -= I_UKV;
                if (r < I_OUT) { const int kb = r / 32, nb = r % 32;
                    tr_item(PIN_(I_WOUT) + (size_t)l * 1024 * 1024, 1024, 32 * nb, 64 * kb, 1024, (bf16*)(ws + WS_WOUT) + ((size_t)l * 1024 + 32 * nb) * 1024, nullptr, false, false, scr, lane); continue; } r -= I_OUT;
                if (r < I_UP) { const int kb = r / 128, nb = r % 128;
                    tr_item(PIN_(I_WUP) + (size_t)l * 1024 * FF, FF, 32 * nb, 64 * kb, 1024, (bf16*)(ws + WS_WUP) + ((size_t)l * FF + 32 * nb) * 1024, PIN_(I_GMLP) + l * DM, false, false, scr, lane); continue; } r -= I_UP;
                { const int kb = r / 32, nb = r % 32;
                    tr_item(PIN_(I_WDN) + (size_t)l * FF * 1024, 1024, 32 * nb, 64 * kb, FF, (bf16*)(ws + WS_WDN) + ((size_t)l * 1024 + 32 * nb) * FF, nullptr, false, false, scr, lane); }
            }
            const float* x = PIN_(I_X);
            for (int row0 = gw * 4; row0 < M; row0 += NGW * 4) {
                f32x4 v[4][4]; float s[4];
#pragma unroll
                for (int q = 0; q < 4; ++q) { const GAS f32x4* xr = (const GAS f32x4*)(x + (size_t)(row0 + q) * DM) + lane;
#pragma unroll
                    for (int j = 0; j < 4; ++j) v[q][j] = xr[64 * j]; }
#pragma unroll
                for (int q = 0; q < 4; ++q) { s[q] = 0.f;
#pragma unroll
                    for (int j = 0; j < 4; ++j) s[q] += pg8::dot4(v[q][j]);
                    s[q] = wave_sum(s[q]);
                    GAS v2u* o8 = (GAS v2u*)(HB + (size_t)(row0 + q) * DM) + lane;
#pragma unroll
                    for (int j = 0; j < 4; ++j) { v2u w; w.x = pk2(v[q][j][0], v[q][j][1]); w.y = pk2(v[q][j][2], v[q][j][3]); o8[64 * j] = w; }
                    if (lane < 16) ((GAS float*)ssq)[(size_t)(row0 + q) * 16 + lane] = lane == 0 ? s[q] : 0.f; }
            }
        } else if (ph == N_PHASES - 1 && (PHM & 2)) {
            int tid; asm volatile("v_mbcnt_lo_u32_b32 %0, -1, 0\n\tv_mbcnt_hi_u32_b32 %0, -1, %0" : "=v"(tid)); tid += wv * 64; const int lane = tid & 63, wave = __builtin_amdgcn_readfirstlane(tid >> 6);
            const int gw = vcu * NWAVES + wave, NGW = G * NWAVES; const float* gf = PIN_(I_GFIN); const float* sq = ssq + (size_t)8 * pg8::SSQ_ARR;
            f32x4 gv[4];
#pragma unroll
            for (int j = 0; j < 4; ++j) gv[j] = ((const GAS f32x4*)gf)[lane + 64 * j];
            for (int row0 = gw * 4; row0 < M; row0 += NGW * 4) {
                v2u w[4][4]; float rs[4];
#pragma unroll
                for (int q = 0; q < 4; ++q) { const GAS v2u* hr = (const GAS v2u*)(HB + (size_t)(row0 + q) * DM) + lane;
#pragma unroll
                    for (int j = 0; j < 4; ++j) w[q][j] = hr[64 * j];
                    rs[q] = rsqrtf(pg8::ssq16(sq + (size_t)(row0 + q) * 16) * (1.f / 1024.f) + 1e-6f); }
#pragma unroll
                for (int q = 0; q < 4; ++q) { GAS f32x4* xr = (GAS f32x4*)(out + (size_t)(row0 + q) * DM) + lane;
#pragma unroll
                    for (int j = 0; j < 4; ++j) { const f32x4 h = {__uint_as_float(w[q][j].x << 16), __uint_as_float(w[q][j].x & 0xffff0000u), __uint_as_float(w[q][j].y << 16), __uint_as_float(w[q][j].y & 0xffff0000u)};
                        xr[64 * j] = h * rs[q] * gv[j]; } }
            }
        } else {
            const int l = (ph - 1) / 6, k = (ph - 1) % 6;
            float* sq_in = ssq + (size_t)(4 * l) * pg8::SSQ_ARR; float* sq_q = sq_in + pg8::SSQ_ARR; float* sq_kv = sq_in + 2 * pg8::SSQ_ARR; float* sq_mid = sq_in + 3 * pg8::SSQ_ARR; float* sq_out = sq_in + 4 * pg8::SSQ_ARR;
            if (k == 0 && (PHM & 4)) {
                for (int rep = 0; rep < REP_Z; ++rep) {
                pg8::Gemm g{HB, (bf16*)(ws + WS_WIN) + (size_t)l * PINP * DM, M, PINP, DM}; pg8::StaticOrder S; S.init(M, PINP, G, bx);
                pg8::EpiZ E{sq_in, sq_q, ws, cs};
                pg8::gemm_phase<pg8::EpiZ, pg8::StaticOrder, true, true>(ldsl, g, S, E, wv); }
            } else if (k == 1 && (PHM & 8)) {
                { pg8::Gemm g{CQ, (bf16*)(ws + WS_WUQ) + (size_t)l * 768 * 256, M, 768, 256}; pg8::StaticOrder S; S.init(M, 768, G, bx);
                  pg8::EpiQ E{sq_q, Qm, cs};
                  pg8::gemm_phase<pg8::EpiQ, pg8::StaticOrder, true, true>(ldsl, g, S, E, wv); }
                { pg8::Gemm g{CKV, (bf16*)(ws + WS_WUKV) + (size_t)l * 1024 * 256, M, 1024, 256}; pg8::StaticOrder S; S.init(M, 1024, G, bx);
                  pg8::EpiRow<0, 4> E{sq_kv, 1.f / 256.f, KV, 1024};
                  pg8::gemm_phase<pg8::EpiRow<0, 4>, pg8::StaticOrder, true, true>(ldsl, g, S, E, wv); }
            } else if (k == 2 && (PHM & 16)) {
                const int NU = 2048;
                for (int rep = 0; rep < REP_MLA; ++rep) for (int i = 0; i * G + vcu < NU; ++i) {
                    int bh, qb; if (G == 256) { bh = (vcu >> 3) * 8 + i; qb = vcu & 7; } else { const int u = i * G + vcu; bh = u >> 3; qb = u & 7; }
                    const int b = bh >> 3, h = bh & 7; const size_t r0 = (size_t)b * SEQ;
                    att::mla_unit((const att::bf16*)Qm + (r0 + qb * 256) * 768 + h * 96, (const att::bf16*)KV + r0 * 1024 + h * 128, (const att::bf16*)KR + r0 * 32,
                                  (att::bf16*)Ob + (r0 + qb * 256) * 1024 + h * 64, (char*)lds, wv);
                }
                float lam;
                int tid; asm volatile("v_mbcnt_lo_u32_b32 %0, -1, 0\n\tv_mbcnt_hi_u32_b32 %0, -1, %0" : "=v"(tid)); tid += wv * 64; const int lane = tid & 63;
                { const float a = ((const GAS float*)PIN_(I_LQ1))[l * 64 + lane] * ((const GAS float*)PIN_(I_LK1))[l * 64 + lane], b = ((const GAS float*)PIN_(I_LQ2))[l * 64 + lane] * ((const GAS float*)PIN_(I_LK2))[l * 64 + lane];
                  lam = expf(wave_sum(a)) - expf(wave_sum(b)) + (l == 0 ? PL->lam_init0 : PL->lam_init1); lam = __uint_as_float(__builtin_amdgcn_readfirstlane(__float_as_uint(lam))); }
                const float outscale = __uint_as_float(__builtin_amdgcn_readfirstlane(__float_as_uint(1.f - (l == 0 ? PL->lam_init0 : PL->lam_init1))));
                for (int rep = 0; rep < REP_DIFF; ++rep) for (int i = 0; i * G + vcu < NU; ++i) {
                    int bh, qb; if (G == 256) { bh = (vcu >> 3) * 4 + (i >> 1); qb = (i & 1) * 8 + (vcu & 7); } else { const int u = i * G + vcu; bh = u >> 4; qb = u & 15; }
                    const int b = bh >> 2, h = bh & 3; const size_t r0 = (size_t)b * SEQ;
                    const float nslope2 = -exp2f(-2.f * (float)(h + 1)) * K_LOG2E;
                    att::diff_unit((const att::bf16*)DQ + (r0 + qb * 128) * 512 + h * 128, (const att::bf16*)DK + r0 * 512 + h * 128, (const att::bf16*)DV + r0 * 512 + h * 128,
                                   (att::bf16*)Ob + (r0 + qb * 128) * 1024 + 512 + h * 128, qb * 128, nslope2, lam, PIN_(I_GSUB) + l * 128, outscale, (char*)lds, wv);
                }
            } else if ((k == 3 || k == 5) && (PHM & 32)) {
                const bool dn = (k == 5);
                pg8::Gemm g{dn ? HID : Ob, dn ? (bf16*)(ws + WS_WDN) + (size_t)l * 1024 * FF : (bf16*)(ws + WS_WOUT) + (size_t)l * 1024 * 1024, M, 1024, dn ? FF : 1024};
                pg8::StaticOrder S; S.init(M, 1024, G, bx);
                pg8::EpiRes E{HB, dn ? sq_out : sq_mid};
                pg8::gemm_phase<pg8::EpiRes, pg8::StaticOrder, true, true>(ldsl, g, S, E, wv);
            } else if (PHM & 64) {
                for (int rep = 0; rep < REP_UP; ++rep) {
                pg8::Gemm g{HB, (bf16*)(ws + WS_WUP) + (size_t)l * FF * 1024, M, FF, 1024}; pg8::StaticOrder S; S.init(M, FF, G, bx);
                pg8::EpiRow<1, 16> E{sq_mid, 1.f / 1024.f, HID, FF};
                pg8::gemm_phase<pg8::EpiRow<1, 16>, pg8::StaticOrder, true, true>(ldsl, g, S, E, wv); }
            }
        }
    }
}

extern "C" void kernel_launch(void* const* d_in, const int* in_sizes, int n_in, void* d_out, int out_size, void* d_ws, size_t ws_size, hipStream_t stream) {
    static int grid = 0;
    if (grid == 0) {
        if (n_in != 17 || in_sizes[0] != M * DM || out_size != M * DM || ws_size < WS_END) { fprintf(stderr, "kernel_launch: shape/workspace mismatch (n_in %d, ws %zu)\n", n_in, ws_size); grid = -1; return; }
        int dev = 0, cus = 0, per_cu = 0;
        hipGetDevice(&dev); hipDeviceGetAttribute(&cus, hipDeviceAttributeMultiprocessorCount, dev);
        if (hipFuncSetAttribute((const void*)fwd_mega, hipFuncAttributeMaxDynamicSharedMemorySize, LDS_BYTES) != hipSuccess) { fprintf(stderr, "kernel_launch: hipFuncSetAttribute failed\n"); grid = -1; return; }
        if (hipOccupancyMaxActiveBlocksPerMultiprocessor(&per_cu, (const void*)fwd_mega, NWAVES * 64, LDS_BYTES) != hipSuccess || per_cu < 1) per_cu = 1;
        (void)hipGetLastError();
        grid = cus * per_cu;
    }
    if (grid < 0) return;
    if (hipMemsetAsync((char*)d_ws + WS_BAR, 0, BAR_BYTES, stream) != hipSuccess) { fprintf(stderr, "kernel_launch: memset of the barrier words failed\n"); return; }
    Params p{};
    for (int i = 0; i < 17; ++i) p.in[i] = (const float*)d_in[i];
    p.out = (float*)d_out; p.ws = (unsigned char*)d_ws; p.ph_lo = 0; p.ph_hi = N_PHASES;
    p.lam_init0 = (float)(0.8 - 0.6 * exp(-0.3 * 0.0)); p.lam_init1 = (float)(0.8 - 0.6 * exp(-0.3 * 1.0));
    void* args[] = {&p};
    hipError_t e = hipLaunchCooperativeKernel((void*)fwd_mega, dim3(grid), dim3(NWAVES * 64), args, LDS_BYTES, stream);
    if (e != hipSuccess) fprintf(stderr, "kernel_launch: cooperative launch failed: %s (grid %d)\n", hipGetErrorString(e), grid);
}
```
